# Optimizing an MI355X kernel written in HIP

```python
import jax, jax.numpy as jnp
from jax import lax
import numpy as np

D_MODEL = 1024
BATCH = 2
SEQ = 8192
DEPTH = 2

CHUNK = 64
QBLK = 128
N_ATTN_HEADS = 8
ATTN_HEAD_DIM = 64
N_IDX_HEADS = 8
IDX_HEAD_DIM = 64
TOPK_MAX = 256
N_GLA_HEADS = 4
GLA_HEAD_K = 64
GLA_HEAD_V = 128
GLA_GATE_RANK = 16
GLA_GATE_TAU = 16.0
D_FF = 2816
PLE_DIM = 256
EPS = 1e-6

ATTN_W = N_ATTN_HEADS * ATTN_HEAD_DIM
IDX_Q_W = N_IDX_HEADS * IDX_HEAD_DIM
GLA_K_W = N_GLA_HEADS * GLA_HEAD_K
GLA_V_W = N_GLA_HEADS * GLA_HEAD_V
SPLIT_SIZES = (ATTN_W, ATTN_W, ATTN_W, IDX_Q_W, IDX_HEAD_DIM, N_IDX_HEADS,
               GLA_K_W, GLA_K_W, GLA_V_W, GLA_V_W, GLA_GATE_RANK, D_MODEL, D_MODEL)
W_IN = 5720

kernel_name = "hybrid_dsa_gla_macaron_ple"


def rmsnorm(x, g):
    xf = x.astype(jnp.float32)
    y = xf * lax.rsqrt(jnp.mean(xf * xf, axis=-1, keepdims=True) + EPS)
    return (y * g.astype(jnp.float32)).astype(x.dtype)


def swiglu(h, w_gate, w_up, w_down):
    return (jax.nn.silu(h @ w_gate) * (h @ w_up)) @ w_down


def dsa_attention(q, k, v, qi, ki, wi):
    B, S, H, Dh = q.shape
    topk = min(TOPK_MAX, S // 4)
    nblk = S // QBLK
    kchunk = jnp.arange(S) // CHUNK
    ki32 = ki.astype(jnp.float32)
    idx_scale = IDX_HEAD_DIM ** -0.5 * N_IDX_HEADS ** -0.5
    att_scale = Dh ** -0.5

    def block(i):
        start = i * QBLK
        qb = lax.dynamic_slice_in_dim(q, start, QBLK, axis=1)
        qib = lax.dynamic_slice_in_dim(qi, start, QBLK, axis=1).astype(jnp.float32)
        wib = lax.dynamic_slice_in_dim(wi, start, QBLK, axis=1).astype(jnp.float32)
        sc = jnp.einsum('bqhd,bsd->bqhs', qib, ki32)
        I = jnp.einsum('bqh,bqhs->bqs', wib * idx_scale, jax.nn.relu(sc))
        qchunk = (start + jnp.arange(QBLK)) // CHUNK
        adm = kchunk[None, :] <= qchunk[:, None]
        I = jnp.where(adm[None], I, -jnp.inf)
        vals, idx = lax.top_k(I, topk)
        valid = vals > -jnp.inf
        ksel = jax.vmap(lambda kk, ii: kk[ii])(k, idx)
        vsel = jax.vmap(lambda vv, ii: vv[ii])(v, idx)
        logits = jnp.einsum('bqhd,bqkhd->bqhk', qb, ksel).astype(jnp.float32) * att_scale
        logits = jnp.where(valid[:, :, None, :], logits, -jnp.inf)
        prob = jax.nn.softmax(logits, axis=-1).astype(v.dtype)
        return jnp.einsum('bqhk,bqkhd->bqhd', prob, vsel)

    out = lax.map(block, jnp.arange(nblk))
    return out.transpose(1, 0, 2, 3, 4).reshape(B, S, H, Dh)


def gla_chunked(q, k, v, logg):
    B, S, H, dk = q.shape
    dv = v.shape[-1]
    n = S // CHUNK

    def to_chunks(t):
        return t.astype(jnp.float32).reshape(B, n, CHUNK, H, t.shape[-1]).transpose(1, 0, 3, 2, 4)

    qc, kc, vc, gc = to_chunks(q * (dk ** -0.5)), to_chunks(k), to_chunks(v), to_chunks(logg)
    causal = jnp.tril(jnp.ones((CHUNK, CHUNK), dtype=bool))

    def step(state, inp):
        qb, kb, vb, gb = inp
        b = jnp.cumsum(gb, axis=2)
        o_inter = jnp.einsum('bhtd,bhde->bhte', qb * jnp.exp(b), state)
        diff = b[:, :, :, None, :] - b[:, :, None, :, :]
        decay = jnp.exp(jnp.where(causal[None, None, :, :, None], diff, -jnp.inf))
        attn = jnp.einsum('bhtd,bhsd,bhtsd->bhts', qb, kb, decay)
        o = o_inter + jnp.einsum('bhts,bhse->bhte', attn, vb)
        b_last = b[:, :, -1:, :]
        state = jnp.exp(b_last[:, :, 0, :])[..., None] * state + \
            jnp.einsum('bhsd,bhse->bhde', kb * jnp.exp(b_last - b), vb)
        return state, o

    state0 = jnp.zeros((B, H, dk, dv), jnp.float32)
    _, o = lax.scan(step, state0, (qc, kc, vc, gc))
    return o.transpose(1, 0, 3, 2, 4).reshape(B, S, H, dv).astype(v.dtype)


def token_mixer(h, w_in, gla_gate_w2, gla_gate_b, gla_norm, w_branch_a, w_branch_b, w_out):
    B, S, _ = h.shape
    z = h @ w_in
    cuts = np.cumsum(np.array(SPLIT_SIZES))[:-1].tolist()
    (aq, ak, av, iq, ik, iw, gq, gk, gv, gr, ga, mga, mgb) = jnp.split(z, cuts, axis=-1)
    hd = lambda t, nh: t.reshape(B, S, nh, -1)
    oa = dsa_attention(hd(aq, N_ATTN_HEADS), hd(ak, N_ATTN_HEADS), hd(av, N_ATTN_HEADS),
                       hd(iq, N_IDX_HEADS), ik, iw)
    ya = oa.reshape(B, S, ATTN_W) @ w_branch_a
    glog = jax.nn.log_sigmoid((ga @ gla_gate_w2 + gla_gate_b).astype(jnp.float32)) / GLA_GATE_TAU
    ob = gla_chunked(hd(gq, N_GLA_HEADS), hd(gk, N_GLA_HEADS), hd(gv, N_GLA_HEADS),
                     glog.reshape(B, S, N_GLA_HEADS, GLA_HEAD_K))
    ob = rmsnorm(ob, gla_norm).reshape(B, S, GLA_V_W) * jax.nn.silu(gr)
    yb = ob @ w_branch_b
    merged = jax.nn.sigmoid(mga) * ya + jax.nn.sigmoid(mgb) * yb
    return merged @ w_out


def setup_inputs(seed: int = 0) -> dict:
    key = jax.random.key(seed)
    ks = jax.random.split(key, 24)
    nrm = lambda k, shape, fan: jax.random.normal(k, shape, jnp.float32) * (fan ** -0.5)
    gain = lambda k, shape: 1.0 + 0.01 * jax.random.normal(k, shape, jnp.float32)
    L = DEPTH
    return {
        "x": jax.random.normal(ks[0], (BATCH, SEQ, D_MODEL), jnp.float32),
        "p": jax.random.normal(ks[1], (DEPTH, BATCH, SEQ, PLE_DIM), jnp.float32),
        "w_in": nrm(ks[2], (L, D_MODEL, W_IN), D_MODEL),
        "gla_gate_w2": nrm(ks[3], (L, GLA_GATE_RANK, GLA_K_W), GLA_GATE_RANK),
        "gla_gate_b": 0.1 * jax.random.normal(ks[4], (L, GLA_K_W), jnp.float32),
        "gla_norm": gain(ks[5], (L, GLA_HEAD_V)),
        "w_branch_a": nrm(ks[6], (L, ATTN_W, D_MODEL), ATTN_W),
        "w_branch_b": nrm(ks[7], (L, GLA_V_W, D_MODEL), GLA_V_W),
        "w_out": nrm(ks[8], (L, D_MODEL, D_MODEL), D_MODEL),
        "norm_ff1": gain(ks[9], (L, D_MODEL)),
        "norm_mix": gain(ks[10], (L, D_MODEL)),
        "norm_ff2": gain(ks[11], (L, D_MODEL)),
        "norm_ple": gain(ks[12], (L, D_MODEL)),
        "ff1_w_gate": nrm(ks[13], (L, D_MODEL, D_FF), D_MODEL),
        "ff1_w_up": nrm(ks[14], (L, D_MODEL, D_FF), D_MODEL),
        "ff1_w_down": nrm(ks[15], (L, D_FF, D_MODEL), D_FF),
        "ff2_w_gate": nrm(ks[16], (L, D_MODEL, D_FF), D_MODEL),
        "ff2_w_up": nrm(ks[17], (L, D_MODEL, D_FF), D_MODEL),
        "ff2_w_down": nrm(ks[18], (L, D_FF, D_MODEL), D_FF),
        "ple_w_proj": nrm(ks[19], (L, PLE_DIM, D_MODEL), PLE_DIM),
        "ple_w_gate": nrm(ks[20], (L, D_MODEL, D_MODEL), D_MODEL),
        "norm_final": gain(ks[21], (D_MODEL,)),
    }


def reference(x, p, w_in, gla_gate_w2, gla_gate_b, gla_norm, w_branch_a, w_branch_b, w_out,
              norm_ff1, norm_mix, norm_ff2, norm_ple, ff1_w_gate, ff1_w_up, ff1_w_down,
              ff2_w_gate, ff2_w_up, ff2_w_down, ple_w_proj, ple_w_gate, norm_final):
    for i in range(DEPTH):
        x = x + 0.5 * swiglu(rmsnorm(x, norm_ff1[i]), ff1_w_gate[i], ff1_w_up[i], ff1_w_down[i])
        x = x + token_mixer(rmsnorm(x, norm_mix[i]), w_in[i], gla_gate_w2[i], gla_gate_b[i],
                            gla_norm[i], w_branch_a[i], w_branch_b[i], w_out[i])
        x = x + 0.5 * swiglu(rmsnorm(x, norm_ff2[i]), ff2_w_gate[i], ff2_w_up[i], ff2_w_down[i])
        g = jax.nn.sigmoid(rmsnorm(x, norm_ple[i]) @ ple_w_gate[i])
        x = x + g * (p[i] @ ple_w_proj[i])
    return rmsnorm(x, norm_final)
```

```cpp
#include <hip/hip_runtime.h>
#include <hip/hip_cooperative_groups.h>
#include <cstdio>
#include <cstdint>
namespace cg = cooperative_groups;
namespace pg8 {
#define PG8_LAS __attribute__((address_space(3)))
typedef unsigned short bf16_t;
typedef short bf16x8 __attribute__((ext_vector_type(8)));
typedef float f32x4 __attribute__((ext_vector_type(4)));
typedef unsigned u32x4 __attribute__((ext_vector_type(4)));
constexpr int BM = 256, BK = 64, HALF = 128, HTB = HALF * BK * 2  , STAGE_BYTES = 8 * HTB, NXCD = 8, WGM = 8;

__host__ __device__ __forceinline__ int lds_byte(int r, int c) { const int st = (r >> 4) * 2 + (c >> 5), rr = r & 15, cc = c & 31, ob = rr * 64 + cc * 2; return st * 1024 + (ob ^ (((ob >> 9) & 1) << 5)); }
__host__ __device__ __forceinline__ void stage_rc(int b, int& R, int& C) { const int st = b / 1024, sb = b % 1024, swz = sb ^ (((sb >> 9) & 1) << 5); R = (st >> 1) * 16 + swz / 64; C = (st & 1) * 32 + (swz % 64) / 2; }
__host__ __device__ __forceinline__ int perm32(int rho) { const int n = rho >> 4, i = rho & 15; return 8 * (i >> 2) + 4 * n + (i & 3); }

struct Unit { int pm, pn; };
struct Gemm { const bf16_t* A; const bf16_t* Bt; int M, N, K, lda, ldb; };

struct StaticOrder {
    int nM, nN, nwg, G, c;
    __host__ __device__ void init(int M, int N, int G_, int c_) { nM = M / BM; nN = N / BM; nwg = nM * nN; G = G_; c = c_; }
    __host__ __device__ bool next(int i, Unit& u) const {
        const long L = (long)i * G + c; if (L >= nwg) return false;
        int wgid = (int)L; { const int q = nwg / NXCD, r = nwg % NXCD, xcd = wgid % NXCD, off = wgid / NXCD; wgid = (xcd < r ? xcd * (q + 1) : r * (q + 1) + (xcd - r) * q) + off; }
        const int nig = WGM * nN, gid = wgid / nig, fm = gid * WGM, gsz = (nM - fm) < WGM ? (nM - fm) : WGM;
        u.pm = fm + ((wgid % nig) % gsz); u.pn = (wgid % nig) / gsz; return true;
    }
    __device__ __forceinline__ void a_ready(const Unit&) const {}
    __device__ __forceinline__ void done(const Unit&) const {}
};

__device__ __forceinline__ unsigned cvt_pk_bf16(float lo, float hi) { unsigned r; asm volatile("v_cvt_pk_bf16_f32 %0, %1, %2" : "=v"(r) : "v"(lo), "v"(hi)); return r; }
__device__ __forceinline__ float bf_lo(unsigned w) { return __uint_as_float(w << 16); }
__device__ __forceinline__ float bf_hi(unsigned w) { return __uint_as_float(w & 0xffff0000u); }
__device__ __forceinline__ float sigmoidf_(float x) { return __builtin_amdgcn_rcpf(1.0f + __expf(-x)); }
typedef unsigned u32x2 __attribute__((ext_vector_type(2)));
__device__ __forceinline__ float row_rstd(const float* part, size_t row, int fq) {
    const f32x4 a = ((const f32x4*)(part + row * 16))[fq];
    float s = (a[0] + a[1]) + (a[2] + a[3]);
    s += __shfl_xor(s, 16); s += __shfl_xor(s, 32);
    return 1.0f / sqrtf(s * (1.0f / 1024.0f) + 1e-6f);
}
struct EpiSwiGLU {
    static constexpr bool PERM = true, AFTER_DRAIN = false;
    bf16_t* O; int ldc; const float* part;
    __device__ __forceinline__ void operator()(const f32x4 (&acc)[2][2][4][2], const Unit& u, int wr, int wc, int fr, int fq) const {
        const int col = u.pn * HALF + wc * 32 + 8 * fq;
#pragma unroll
        for (int ai = 0; ai < 2; ++ai)
#pragma unroll
            for (int m = 0; m < 4; ++m) { const size_t row = (size_t)(u.pm * BM + ai * HALF + wr * 64 + m * 16 + fr); float v[8];
#pragma unroll
                for (int n = 0; n < 2; ++n) { const f32x4 g = acc[ai][0][m][n], up = acc[ai][1][m][n];
#pragma unroll
                    for (int j = 0; j < 4; ++j) v[4 * n + j] = g[j] * sigmoidf_(g[j]) * up[j]; }
                u32x4 w; w.x = cvt_pk_bf16(v[0], v[1]); w.y = cvt_pk_bf16(v[2], v[3]); w.z = cvt_pk_bf16(v[4], v[5]); w.w = cvt_pk_bf16(v[6], v[7]);
                *(u32x4*)(O + row * ldc + col) = w; }
    }
};
struct EpiResid {
    static constexpr bool PERM = false, AFTER_DRAIN = false;
    const float* base; float* out; int ldc; float alpha;
    __device__ __forceinline__ void operator()(const f32x4 (&acc)[2][2][4][2], const Unit& u, int wr, int wc, int fr, int fq) const {
        const size_t off0 = (size_t)(u.pm * BM + wr * 64 + fr) * ldc + u.pn * BM + wc * 32 + 4 * fq;
        f32x4 cur[2][2], nxt[2][2];
#pragma unroll
        for (int bj = 0; bj < 2; ++bj)
#pragma unroll
            for (int n = 0; n < 2; ++n) cur[bj][n] = *(const f32x4*)(base + off0 + bj * HALF + n * 16);
#pragma unroll
        for (int gidx = 0; gidx < 8; ++gidx) { const int ai = gidx >> 2, m = gidx & 3; const size_t off = off0 + (size_t)(ai * HALF + m * 16) * ldc;
            if (gidx < 7) { const int ai2 = (gidx + 1) >> 2, m2 = (gidx + 1) & 3; const size_t offn = off0 + (size_t)(ai2 * HALF + m2 * 16) * ldc;
#pragma unroll
                for (int bj = 0; bj < 2; ++bj)
#pragma unroll
                    for (int n = 0; n < 2; ++n) nxt[bj][n] = *(const f32x4*)(base + offn + bj * HALF + n * 16); }
            asm volatile("" ::: "memory");
#pragma unroll
            for (int bj = 0; bj < 2; ++bj)
#pragma unroll
                for (int n = 0; n < 2; ++n) *(f32x4*)(out + off + bj * HALF + n * 16) = cur[bj][n] + acc[ai][bj][m][n] * alpha;
            asm volatile("" ::: "memory");
#pragma unroll
            for (int bj = 0; bj < 2; ++bj)
#pragma unroll
                for (int n = 0; n < 2; ++n) cur[bj][n] = nxt[bj][n]; }
    }
};
struct EpiBf16Mask {
    static constexpr bool PERM = true, AFTER_DRAIN = false;
    bf16_t* O; int ldc; int ncols; const float* part;
    __device__ __forceinline__ void operator()(const f32x4 (&acc)[2][2][4][2], const Unit& u, int wr, int wc, int fr, int fq) const {
        const int col0 = u.pn * BM + wc * 32 + 8 * fq;
        float rsv[2][4];
#pragma unroll
        for (int ai = 0; ai < 2; ++ai)
#pragma unroll
            for (int m = 0; m < 4; ++m) rsv[ai][m] = part ? row_rstd(part, (size_t)(u.pm * BM + ai * HALF + wr * 64 + m * 16 + fr), fq) : 1.0f;
#pragma unroll
        for (int ai = 0; ai < 2; ++ai)
#pragma unroll
            for (int m = 0; m < 4; ++m) { const size_t row = (size_t)(u.pm * BM + ai * HALF + wr * 64 + m * 16 + fr); bf16_t* rowp = O + row * ldc; const float rs = rsv[ai][m];
#pragma unroll
                for (int bj = 0; bj < 2; ++bj) { const f32x4 v0 = acc[ai][bj][m][0] * rs, v1 = acc[ai][bj][m][1] * rs;
                    u32x4 w; w.x = cvt_pk_bf16(v0[0], v0[1]); w.y = cvt_pk_bf16(v0[2], v0[3]); w.z = cvt_pk_bf16(v1[0], v1[1]); w.w = cvt_pk_bf16(v1[2], v1[3]);
                    const int c = col0 + bj * HALF; if (c < ncols) *(u32x4*)(rowp + c) = w; } }
    }
};
template <int MODE> struct EpiMerge {
    static constexpr bool PERM = true, AFTER_DRAIN = false;
    const bf16_t* gate; int ldg; bf16_t* H; int ldh;
    __device__ __forceinline__ void operator()(const f32x4 (&acc)[2][2][4][2], const Unit& u, int wr, int wc, int fr, int fq) const {
        const size_t row0 = (size_t)(u.pm * BM + wr * 64 + fr); const int c0 = u.pn * BM + wc * 32 + 8 * fq;
        u32x4 cg[2], ch[2], ng[2], nh[2];
#pragma unroll
        for (int bj = 0; bj < 2; ++bj) { cg[bj] = *(const u32x4*)(gate + row0 * ldg + c0 + bj * HALF); if (MODE == 1) ch[bj] = *(const u32x4*)(H + row0 * ldh + c0 + bj * HALF); }
#pragma unroll
        for (int gidx = 0; gidx < 8; ++gidx) { const int ai = gidx >> 2, m = gidx & 3; const size_t row = row0 + ai * HALF + m * 16;
            if (gidx < 7) { const size_t rn = row0 + ((gidx + 1) >> 2) * HALF + ((gidx + 1) & 3) * 16;
#pragma unroll
                for (int bj = 0; bj < 2; ++bj) { ng[bj] = *(const u32x4*)(gate + rn * ldg + c0 + bj * HALF); if (MODE == 1) nh[bj] = *(const u32x4*)(H + rn * ldh + c0 + bj * HALF); } }
            asm volatile("" ::: "memory");
#pragma unroll
            for (int bj = 0; bj < 2; ++bj) { const f32x4 a0 = acc[ai][bj][m][0], a1 = acc[ai][bj][m][1]; const u32x4 gw = cg[bj];
                float v0 = sigmoidf_(bf_lo(gw.x)) * a0[0], v1 = sigmoidf_(bf_hi(gw.x)) * a0[1], v2 = sigmoidf_(bf_lo(gw.y)) * a0[2], v3 = sigmoidf_(bf_hi(gw.y)) * a0[3];
                float v4 = sigmoidf_(bf_lo(gw.z)) * a1[0], v5 = sigmoidf_(bf_hi(gw.z)) * a1[1], v6 = sigmoidf_(bf_lo(gw.w)) * a1[2], v7 = sigmoidf_(bf_hi(gw.w)) * a1[3];
                if (MODE == 1) { const u32x4 hw = ch[bj]; v0 += bf_lo(hw.x); v1 += bf_hi(hw.x); v2 += bf_lo(hw.y); v3 += bf_hi(hw.y); v4 += bf_lo(hw.z); v5 += bf_hi(hw.z); v6 += bf_lo(hw.w); v7 += bf_hi(hw.w); }
                u32x4 w; w.x = cvt_pk_bf16(v0, v1); w.y = cvt_pk_bf16(v2, v3); w.z = cvt_pk_bf16(v4, v5); w.w = cvt_pk_bf16(v6, v7);
                *(u32x4*)(H + row * ldh + c0 + bj * HALF) = w; }
            asm volatile("" ::: "memory");
#pragma unroll
            for (int bj = 0; bj < 2; ++bj) { cg[bj] = ng[bj]; if (MODE == 1) ch[bj] = nh[bj]; } }
    }
};
struct EpiF32 {
    static constexpr bool PERM = false, AFTER_DRAIN = false;
    float* O; int ldc;
    __device__ __forceinline__ void operator()(const f32x4 (&acc)[2][2][4][2], const Unit& u, int wr, int wc, int fr, int fq) const {
#pragma unroll
        for (int ai = 0; ai < 2; ++ai)
#pragma unroll
            for (int m = 0; m < 4; ++m) { const size_t off = (size_t)(u.pm * BM + ai * HALF + wr * 64 + m * 16 + fr) * ldc + u.pn * BM + wc * 32 + 4 * fq;
#pragma unroll
                for (int bj = 0; bj < 2; ++bj)
#pragma unroll
                    for (int n = 0; n < 2; ++n) *(f32x4*)(O + off + bj * HALF + n * 16) = acc[ai][bj][m][n]; }
    }
};
struct EpiPle {
    static constexpr bool PERM = false, AFTER_DRAIN = false;
    const float* pp; float* out; int ldc; const float* part;
    __device__ __forceinline__ void operator()(const f32x4 (&acc)[2][2][4][2], const Unit& u, int wr, int wc, int fr, int fq) const {
        const size_t off0 = (size_t)(u.pm * BM + wr * 64 + fr) * ldc + u.pn * BM + wc * 32 + 4 * fq;
        f32x4 cp[2][2], cx[2][2], np[2][2], nx[2][2];
#pragma unroll
        for (int bj = 0; bj < 2; ++bj)
#pragma unroll
            for (int n = 0; n < 2; ++n) { cp[bj][n] = *(const f32x4*)(pp + off0 + bj * HALF + n * 16); cx[bj][n] = *(const f32x4*)(out + off0 + bj * HALF + n * 16); }
#pragma unroll
        for (int gidx = 0; gidx < 8; ++gidx) { const int ai = gidx >> 2, m = gidx & 3; const size_t off = off0 + (size_t)(ai * HALF + m * 16) * ldc;
            if (gidx < 7) { const int ai2 = (gidx + 1) >> 2, m2 = (gidx + 1) & 3; const size_t offn = off0 + (size_t)(ai2 * HALF + m2 * 16) * ldc;
#pragma unroll
                for (int bj = 0; bj < 2; ++bj)
#pragma unroll
                    for (int n = 0; n < 2; ++n) { np[bj][n] = *(const f32x4*)(pp + offn + bj * HALF + n * 16); nx[bj][n] = *(const f32x4*)(out + offn + bj * HALF + n * 16); } }
            asm volatile("" ::: "memory");
#pragma unroll
            for (int bj = 0; bj < 2; ++bj)
#pragma unroll
                for (int n = 0; n < 2; ++n) { const f32x4 a = acc[ai][bj][m][n]; const f32x4 p = cp[bj][n]; f32x4 x = cx[bj][n];
                    x[0] += sigmoidf_(a[0]) * p[0]; x[1] += sigmoidf_(a[1]) * p[1]; x[2] += sigmoidf_(a[2]) * p[2]; x[3] += sigmoidf_(a[3]) * p[3];
                    *(f32x4*)(out + off + bj * HALF + n * 16) = x; }
            asm volatile("" ::: "memory");
#pragma unroll
            for (int bj = 0; bj < 2; ++bj)
#pragma unroll
                for (int n = 0; n < 2; ++n) { cp[bj][n] = np[bj][n]; cx[bj][n] = nx[bj][n]; } }
    }
};

template <class Epi, class Sched, bool ALIGN_EPI = false, bool SP2 = false>
__device__ __forceinline__ void gemm_phase(PG8_LAS unsigned char* lds, const Gemm g, const Sched& S, const Epi& E, const int tid) {
    const int wid = __builtin_amdgcn_readfirstlane(tid >> 6), lane = tid & 63, wr = wid >> 2, wc = wid & 3, fr = lane & 15, fq = lane >> 4;
    int K = g.K; asm volatile("" : "+s"(K)); const int nt = K / BK;
    unsigned voffA[2], voffB[2];
#pragma unroll
    for (int i = 0; i < 2; ++i) { int R, C; stage_rc(tid * 16 + i * 8192, R, C); const int Rb = Epi::PERM ? ((R & ~31) + perm32(R & 31)) : R;
        voffA[i] = (unsigned)(R * g.lda + C) * 2u; voffB[i] = (unsigned)(Rb * g.ldb + C) * 2u; }
    const size_t kstep = (size_t)(BK * 2);
    const size_t hstepA = (size_t)HALF * g.lda * 2, hstepB = (size_t)HALF * g.ldb * 2;
    const size_t tstepA = 2 * hstepA, tstepB = 2 * hstepB;
    const unsigned ldsw = (unsigned)wid * 1024u;
    const int aoff = lds_byte(wr * 64 + fr, fq * 8), boff = lds_byte(wc * 32 + fr, fq * 8);
#define PG8_SA(b, h) (((b) * 2 + (h)) * HTB)
#define PG8_SB(b, h) ((4 + (b) * 2 + (h)) * HTB)
#define PG8_STAGE(bufoff, gbase, voff) do { _Pragma("unroll") for (int _i = 0; _i < 2; ++_i) \
        __builtin_amdgcn_global_load_lds((const unsigned*)((const char*)(gbase) + (voff)[_i]), (PG8_LAS unsigned*)(lds + (bufoff) + ldsw + _i * 8192), 16, 0, 0); } while (0)
#define PG8_LDA(dst, b, h) do { _Pragma("unroll") for (int m = 0; m < 4; ++m) _Pragma("unroll") for (int k = 0; k < 2; ++k) dst[m][k] = *(const PG8_LAS bf16x8*)(lds + PG8_SA(b, h) + aoff + m * 2048 + k * 1024); } while (0)
#define PG8_LDB(dst, b, h) do { _Pragma("unroll") for (int n = 0; n < 2; ++n) _Pragma("unroll") for (int k = 0; k < 2; ++k) dst[n][k] = *(const PG8_LAS bf16x8*)(lds + PG8_SB(b, h) + boff + n * 2048 + k * 1024); } while (0)
#define PG8_MMA(ai, bj, At, Bt) do { __builtin_amdgcn_s_setprio(1); _Pragma("unroll") for (int m = 0; m < 4; ++m) _Pragma("unroll") for (int n = 0; n < 2; ++n) _Pragma("unroll") for (int k = 0; k < 2; ++k) \
        acc[ai][bj][m][n] = __builtin_amdgcn_mfma_f32_16x16x32_bf16(Bt[n][k], At[m][k], acc[ai][bj][m][n], 0, 0, 0); __builtin_amdgcn_s_setprio(0); } while (0)
#define PG8_WAIT_V(n) asm volatile("s_waitcnt vmcnt(" #n ")" ::: "memory")
#define PG8_WAIT_L(n) asm volatile("s_waitcnt lgkmcnt(" #n ")" ::: "memory")
#define PG8_BAR __builtin_amdgcn_s_barrier()
#define PG8_SCHED __builtin_amdgcn_sched_barrier(0)
    Unit cur, nxt; int ui = 0;
    if (!S.next(0, cur)) return;
    f32x4 acc[2][2][4][2];
#pragma unroll
    for (int a = 0; a < 2; ++a)
#pragma unroll
        for (int b = 0; b < 2; ++b)
#pragma unroll
            for (int m = 0; m < 4; ++m)
#pragma unroll
                for (int n = 0; n < 2; ++n) acc[a][b][m][n] = (f32x4){0.f, 0.f, 0.f, 0.f};
    bf16x8 At[4][2], B0[2][2], B1[2][2];
    const char* cA = (const char*)g.A + (size_t)cur.pm * tstepA; const char* cB = (const char*)g.Bt + (size_t)cur.pn * tstepB;
    S.a_ready(cur);
    if constexpr (SP2) {
        PG8_STAGE(PG8_SB(0, 0), cB, voffB); PG8_STAGE(PG8_SB(0, 1), cB + hstepB, voffB); PG8_STAGE(PG8_SA(0, 0), cA, voffA); PG8_STAGE(PG8_SA(0, 1), cA + hstepA, voffA);
        if (wr == 1) PG8_BAR;
        PG8_WAIT_V(2); PG8_BAR;
        PG8_STAGE(PG8_SB(1, 0), cB + kstep, voffB); PG8_STAGE(PG8_SA(1, 0), cA + kstep, voffA); PG8_STAGE(PG8_SB(1, 1), cB + hstepB + kstep, voffB);
        PG8_WAIT_V(6); PG8_BAR;
    } else {
        PG8_STAGE(PG8_SB(0, 0), cB, voffB); PG8_STAGE(PG8_SA(0, 0), cA, voffA); PG8_STAGE(PG8_SB(0, 1), cB + hstepB, voffB); PG8_STAGE(PG8_SA(0, 1), cA + hstepA, voffA);
        if (wr == 1) PG8_BAR;
        PG8_WAIT_V(4); PG8_BAR;
        PG8_STAGE(PG8_SB(1, 0), cB + kstep, voffB); PG8_STAGE(PG8_SA(1, 0), cA + kstep, voffA); PG8_STAGE(PG8_SB(1, 1), cB + hstepB + kstep, voffB);
        PG8_WAIT_V(6); PG8_BAR;
    }
    for (;;) {
        const bool has_next = S.next(ui + 1, nxt);
        const char* nA = has_next ? (const char*)g.A + (size_t)nxt.pm * tstepA : cA; const char* nB = has_next ? (const char*)g.Bt + (size_t)nxt.pn * tstepB : cB;
        for (int t = 0; t < nt; t += 2) {
            const bool last = (t == nt - 2);
            const char* a1 = cA + (size_t)(t + 1) * kstep;
            const char* a2 = last ? nA : cA + (size_t)(t + 2) * kstep; const char* b2 = last ? nB : cB + (size_t)(t + 2) * kstep;
            const char* a3 = a2 + kstep; const char* b3 = b2 + kstep;
            if (last && has_next) S.a_ready(nxt);
            if constexpr (SP2) {
            PG8_LDB(B0, 0, 0); PG8_LDB(B1, 0, 1); PG8_SCHED; PG8_LDA(At, 0, 0); PG8_STAGE(PG8_SA(1, 1), a1 + hstepA, voffA);
            PG8_WAIT_V(8); PG8_WAIT_L(0); PG8_BAR; PG8_MMA(0, 0, At, B0); PG8_MMA(0, 1, At, B1); PG8_BAR; PG8_SCHED;
            PG8_LDA(At, 0, 1); PG8_STAGE(PG8_SB(0, 0), b2, voffB); PG8_STAGE(PG8_SB(0, 1), b2 + hstepB, voffB); PG8_STAGE(PG8_SA(0, 0), a2, voffA);
            PG8_WAIT_V(8); PG8_WAIT_L(0); PG8_BAR; PG8_MMA(1, 0, At, B0); PG8_MMA(1, 1, At, B1); PG8_BAR; PG8_SCHED;
            PG8_LDB(B0, 1, 0); PG8_LDB(B1, 1, 1); PG8_SCHED; PG8_LDA(At, 1, 0); PG8_STAGE(PG8_SA(0, 1), a2 + hstepA, voffA);
            PG8_WAIT_V(8); PG8_WAIT_L(0); PG8_BAR; PG8_MMA(0, 0, At, B0); PG8_MMA(0, 1, At, B1); PG8_BAR; PG8_SCHED;
            PG8_LDA(At, 1, 1); PG8_STAGE(PG8_SB(1, 0), b3, voffB); PG8_STAGE(PG8_SB(1, 1), b3 + hstepB, voffB); PG8_STAGE(PG8_SA(1, 0), a3, voffA);
            PG8_WAIT_V(8); PG8_WAIT_L(0); PG8_BAR; PG8_MMA(1, 0, At, B0); PG8_MMA(1, 1, At, B1); PG8_BAR; PG8_SCHED;
            } else {
            PG8_LDB(B0, 0, 0); PG8_SCHED; PG8_LDA(At, 0, 0); PG8_STAGE(PG8_SA(1, 1), a1 + hstepA, voffA);
            PG8_WAIT_L(8); PG8_BAR; PG8_WAIT_L(0); PG8_MMA(0, 0, At, B0); PG8_BAR; PG8_SCHED;
            PG8_LDB(B1, 0, 1); PG8_STAGE(PG8_SB(0, 0), b2, voffB);
            PG8_BAR; PG8_WAIT_L(0); PG8_MMA(0, 1, At, B1); PG8_BAR;
            PG8_LDA(At, 0, 1); PG8_STAGE(PG8_SA(0, 0), a2, voffA);
            PG8_BAR; PG8_WAIT_L(0); PG8_MMA(1, 0, At, B0); PG8_BAR; PG8_SCHED;
            PG8_STAGE(PG8_SB(0, 1), b2 + hstepB, voffB);
            PG8_WAIT_V(6); PG8_BAR; PG8_MMA(1, 1, At, B1); PG8_BAR;
            PG8_LDB(B0, 1, 0); PG8_SCHED; PG8_LDA(At, 1, 0); PG8_STAGE(PG8_SA(0, 1), a2 + hstepA, voffA);
            PG8_WAIT_L(8); PG8_BAR; PG8_WAIT_L(0); PG8_MMA(0, 0, At, B0); PG8_BAR; PG8_SCHED;
            PG8_LDB(B1, 1, 1); PG8_STAGE(PG8_SB(1, 0), b3, voffB);
            PG8_BAR; PG8_WAIT_L(0); PG8_MMA(0, 1, At, B1); PG8_BAR;
            PG8_LDA(At, 1, 1); PG8_STAGE(PG8_SA(1, 0), a3, voffA);
            PG8_BAR; PG8_WAIT_L(0); PG8_MMA(1, 0, At, B0); PG8_BAR; PG8_SCHED;
            PG8_STAGE(PG8_SB(1, 1), b3 + hstepB, voffB);
            PG8_WAIT_V(6); PG8_BAR; PG8_MMA(1, 1, At, B1); PG8_BAR;
            }
        }
        if constexpr (ALIGN_EPI) { if (wr == 0) PG8_BAR; }
        if constexpr (!Epi::AFTER_DRAIN) { E(acc, cur, wr, wc, fr, fq); S.done(cur); }
        if (!has_next) break;
#pragma unroll
        for (int a = 0; a < 2; ++a)
#pragma unroll
            for (int b = 0; b < 2; ++b)
#pragma unroll
                for (int m = 0; m < 4; ++m)
#pragma unroll
                    for (int n = 0; n < 2; ++n) acc[a][b][m][n] = (f32x4){0.f, 0.f, 0.f, 0.f};
        cur = nxt; cA = nA; cB = nB; ++ui;
        if constexpr (ALIGN_EPI) { if (wr == 1) PG8_BAR; }
    }
    PG8_WAIT_V(0);
    if constexpr (!ALIGN_EPI) { if (wr == 0) PG8_BAR; }
    PG8_BAR;
    if constexpr (Epi::AFTER_DRAIN) { E.fused(acc, cur, wr, wc, fr, fq, lds, wid, lane); S.done(cur); }
#undef PG8_SA
#undef PG8_SB
#undef PG8_STAGE
#undef PG8_LDA
#undef PG8_LDB
#undef PG8_MMA
#undef PG8_WAIT_V
#undef PG8_WAIT_L
#undef PG8_BAR
#undef PG8_SCHED
}
}
constexpr int NWAVES = 8, NTHREADS = 512;
constexpr int SEQ = 8192, NB = 2, T = NB * SEQ, D = 1024, FF = 2816, DEPTH = 2, PLE = 256;
constexpr int WIN = 5720, WINP = 5888, ZS = 5720;
constexpr int C_AQ = 0, C_AK = 512, C_AV = 1024, C_IQ = 1536, C_IK = 2048, C_IW = 2112, C_GQ = 2120, C_GK = 2376, C_GV = 2632, C_GR = 3144, C_GA = 3656, C_MGA = 3672, C_MGB = 4696;
constexpr float EPS = 1e-6f;
constexpr size_t MiB = 1u << 20;
constexpr size_t WB_GU1 = 0, WB_D1 = WB_GU1 + (size_t)2 * FF * D * 2, WB_IN = WB_D1 + (size_t)D * FF * 2, WB_A = WB_IN + (size_t)WINP * D * 2, WB_B = WB_A + (size_t)D * 512 * 2,
                 WB_O = WB_B + (size_t)D * 512 * 2, WB_GU2 = WB_O + (size_t)D * D * 2, WB_D2 = WB_GU2 + (size_t)2 * FF * D * 2, WB_PG = WB_D2 + (size_t)D * FF * 2, WB_PP = WB_PG + (size_t)D * D * 2,
                 WB_END = WB_PP + (size_t)D * PLE * 2;
static_assert(WB_END <= 52 * MiB, "weight copies");
constexpr size_t WS_H = 52 * MiB;
constexpr size_t WS_SMALL = 84 * MiB;
constexpr size_t WS_CTL = WS_SMALL + 512 * 1024, CTL_BYTES = 16384;
constexpr size_t WS_Z = 85 * MiB;
constexpr size_t WS_PB = WS_Z + 140 * MiB;
constexpr size_t WS_XB2 = WS_Z + 100 * MiB;
constexpr size_t WS_END = WS_Z + (size_t)T * ZS * 2;
constexpr size_t WS_MASK = 264 * MiB, WS_PART = WS_MASK + (size_t)T * 256 * 4, WS_ALL = WS_PART + (size_t)T * 16 * 4;
static_assert(WS_END <= WS_MASK, "ws map");
constexpr int RING_BYTES = 131072, LDSCTL_OFF = RING_BYTES, LDS_BYTES = 163840;

#define GAS __attribute__((address_space(1)))
#define LAS __attribute__((address_space(3)))
typedef unsigned short bf16;
typedef unsigned v4u __attribute__((ext_vector_type(4)));
typedef unsigned v2u __attribute__((ext_vector_type(2)));
typedef float f32x4 __attribute__((ext_vector_type(4)));
typedef float f32x16 __attribute__((ext_vector_type(16)));
typedef short bf16x8 __attribute__((ext_vector_type(8)));
#define LDS_FENCE() asm volatile("s_waitcnt lgkmcnt(0)" ::: "memory")
__device__ __forceinline__ unsigned f2bf(float f) { unsigned u = __builtin_bit_cast(unsigned, f); return (u + 0x7fffu + ((u >> 16) & 1u)) >> 16; }
__device__ __forceinline__ unsigned pk2(float lo, float hi) { return f2bf(lo) | (f2bf(hi) << 16); }
__device__ __forceinline__ float bflo(unsigned w) { return __uint_as_float(w << 16); }
__device__ __forceinline__ float bfhi(unsigned w) { return __uint_as_float(w & 0xffff0000u); }
__device__ __forceinline__ float wave_sum(float v) {
#pragma unroll
    for (int o = 1; o < 64; o <<= 1) v += __shfl_xor(v, o);
    return v;
}

struct Args { const float* in[22]; float* out; unsigned char* ws; int ph_lo, ph_hi; };
typedef const Args __attribute__((address_space(4))) * ArgsP;

__device__ __forceinline__ void transpose_item(const float* W, int K, int N, bf16* WT, int mode, LAS float* scr, int item, int lane, const float* gk = nullptr) {
    const int nblk = (N + 31) / 32, kb = item / nblk, nb = item % nblk, k0 = 64 * kb, n0 = 32 * nb;
    const int nn = n0 + (lane & 31); const bool okr = nn < N;
#pragma unroll 8
    for (int i = 0; i < 32; ++i) { const int kk = 2 * i + (lane >> 5); float w = okr ? W[(size_t)(k0 + kk) * N + nn] : 0.f; if (gk) w *= gk[k0 + kk]; scr[kk * 33 + (lane & 31)] = w; }
    LDS_FENCE();
    const int c = lane & 7;
#pragma unroll
    for (int j = 0; j < 4; ++j) { const int nl = (lane >> 3) + 8 * j; const int n = n0 + nl; const LAS float* s = scr + (8 * c) * 33 + nl;
        v4u o; o.x = pk2(s[0 * 33], s[1 * 33]); o.y = pk2(s[2 * 33], s[3 * 33]); o.z = pk2(s[4 * 33], s[5 * 33]); o.w = pk2(s[6 * 33], s[7 * 33]);
        const int row = mode == 0 ? n : (256 * (n >> 7) + (n & 127) + (mode == 2 ? 128 : 0));
        if (n < N) *(v4u*)(WT + (size_t)row * K + k0 + 8 * c) = o; }
    LDS_FENCE();
}
struct CvtDesc { const float* W; bf16* WT; int K, N, mode, item; };
__device__ __forceinline__ CvtDesc cvt_decode(ArgsP a, int L, int it) {
    constexpr int I_GU = (D / 64) * (FF / 32), I_DN = (FF / 64) * (D / 32), I_IN = (D / 64) * ((WIN + 31) / 32), I_BR = (512 / 64) * (D / 32), I_SQ = (D / 64) * (D / 32);
    int r = it;
    if (r < I_GU) return CvtDesc{a->in[13] + (size_t)L * D * FF, (bf16*)(a->ws + WB_GU1), D, FF, 1, r}; r -= I_GU;
    if (r < I_GU) return CvtDesc{a->in[14] + (size_t)L * D * FF, (bf16*)(a->ws + WB_GU1), D, FF, 2, r}; r -= I_GU;
    if (r < I_DN) return CvtDesc{a->in[15] + (size_t)L * D * FF, (bf16*)(a->ws + WB_D1), FF, D, 0, r}; r -= I_DN;
    if (r < I_IN) return CvtDesc{a->in[2] + (size_t)L * D * WIN, (bf16*)(a->ws + WB_IN), D, WIN, 0, r}; r -= I_IN;
    if (r < I_BR) return CvtDesc{a->in[6] + (size_t)L * 512 * D, (bf16*)(a->ws + WB_A), 512, D, 0, r}; r -= I_BR;
    if (r < I_BR) return CvtDesc{a->in[7] + (size_t)L * 512 * D, (bf16*)(a->ws + WB_B), 512, D, 0, r}; r -= I_BR;
    if (r < I_SQ) return CvtDesc{a->in[8] + (size_t)L * D * D, (bf16*)(a->ws + WB_O), D, D, 0, r}; r -= I_SQ;
    if (r < I_GU) return CvtDesc{a->in[16] + (size_t)L * D * FF, (bf16*)(a->ws + WB_GU2), D, FF, 1, r}; r -= I_GU;
    if (r < I_GU) return CvtDesc{a->in[17] + (size_t)L * D * FF, (bf16*)(a->ws + WB_GU2), D, FF, 2, r}; r -= I_GU;
    if (r < I_DN) return CvtDesc{a->in[18] + (size_t)L * D * FF, (bf16*)(a->ws + WB_D2), FF, D, 0, r}; r -= I_DN;
    if (r < I_SQ) return CvtDesc{a->in[20] + (size_t)L * D * D, (bf16*)(a->ws + WB_PG), D, D, 0, r}; r -= I_SQ;
    return CvtDesc{a->in[19] + (size_t)L * PLE * D, (bf16*)(a->ws + WB_PP), PLE, D, 0, r};
}
__device__ __forceinline__ void cvt_load(const CvtDesc& d, int lane, float (&pre)[32]) {
    const int nblk = (d.N + 31) / 32, kb = d.item / nblk, nb = d.item % nblk, k0 = 64 * kb, n0 = 32 * nb;
    const int nn = n0 + (lane & 31); const bool okr = nn < d.N; const float* p = d.W + (size_t)(k0 + (lane >> 5)) * d.N + (okr ? nn : 0);
#pragma unroll
    for (int i = 0; i < 32; ++i) { const float w = p[(size_t)(2 * i) * d.N]; pre[i] = okr ? w : 0.f; }
}
__device__ __forceinline__ void convert_weights(ArgsP a, int L, LAS unsigned char* lds, int wave, int lane, const int TID, const int BID) {
    LAS float* scr = (LAS float*)(lds + wave * 16384);
    const int gw = BID * NWAVES + wave, NGW = gridDim.x * NWAVES;
    constexpr int I_GU = (D / 64) * (FF / 32), I_DN = (FF / 64) * (D / 32), I_IN = (D / 64) * ((WIN + 31) / 32), I_BR = (512 / 64) * (D / 32), I_SQ = (D / 64) * (D / 32), I_PP = (PLE / 64) * (D / 32);
    constexpr int NITEMS = 4 * I_GU + 2 * I_DN + I_IN + 2 * I_BR + 2 * I_SQ + I_PP;
    int it = gw;
    if (it < NITEMS) {
        float pre[32];
        CvtDesc cur = cvt_decode(a, L, it); cvt_load(cur, lane, pre);
        for (;;) {
#pragma unroll
            for (int i = 0; i < 32; ++i) scr[(2 * i + (lane >> 5)) * 33 + (lane & 31)] = pre[i];
            const int nit = it + NGW; const bool hn = nit < NITEMS;
            const CvtDesc nxt = cvt_decode(a, L, hn ? nit : it);
            if (hn) cvt_load(nxt, lane, pre);
            LDS_FENCE();
            { const int nblk = (cur.N + 31) / 32, kb = cur.item / nblk, nb = cur.item % nblk, k0 = 64 * kb, n0 = 32 * nb; const int c = lane & 7;
#pragma unroll
              for (int j = 0; j < 4; ++j) { const int nl = (lane >> 3) + 8 * j; const int n = n0 + nl; const LAS float* sp = scr + (8 * c) * 33 + nl;
                  v4u o; o.x = pk2(sp[0 * 33], sp[1 * 33]); o.y = pk2(sp[2 * 33], sp[3 * 33]); o.z = pk2(sp[4 * 33], sp[5 * 33]); o.w = pk2(sp[6 * 33], sp[7 * 33]);
                  const int row = cur.mode == 0 ? n : (256 * (n >> 7) + (n & 127) + (cur.mode == 2 ? 128 : 0));
                  if (n < cur.N) *(v4u*)(cur.WT + (size_t)row * cur.K + k0 + 8 * c) = o; } }
            LDS_FENCE();
            if (!hn) break;
            cur = nxt; it = nit;
        }
    }
    { v4u* p = (v4u*)(a->ws + WB_IN + (size_t)WIN * D * 2); const int n16 = (WINP - WIN) * D * 2 / 16;
      for (int i = BID * NTHREADS + TID; i < n16; i += gridDim.x * NTHREADS) p[i] = (v4u){0u, 0u, 0u, 0u}; }
}
__device__ __forceinline__ void norm_rows(const float* x, const float* g, bf16* H, int wave, int lane, const int TID, const int BID) {
    const int gw = BID * NWAVES + wave, NGW = gridDim.x * NWAVES;
    f32x4 gv[4];
#pragma unroll
    for (int j = 0; j < 4; ++j) gv[j] = ((const f32x4*)g)[lane + 64 * j];
    for (int m = gw; m < T; m += 8 * NGW) {
        f32x4 v[8][4]; float ss[8]; int rowi[8];
#pragma unroll
        for (int r = 0; r < 8; ++r) { const int mr = m + r * NGW; rowi[r] = mr < T ? mr : m; const f32x4* xr = (const f32x4*)(x + (size_t)rowi[r] * D) + lane;
#pragma unroll
            for (int j = 0; j < 4; ++j) v[r][j] = xr[64 * j]; }
#pragma unroll
        for (int r = 0; r < 8; ++r) { float s = 0.f;
#pragma unroll
            for (int j = 0; j < 4; ++j) s += (v[r][j].x * v[r][j].x + v[r][j].y * v[r][j].y) + (v[r][j].z * v[r][j].z + v[r][j].w * v[r][j].w);
            ss[r] = s; }
#pragma unroll
        for (int o = 1; o < 64; o <<= 1) {
#pragma unroll
            for (int r = 0; r < 8; ++r) ss[r] += __shfl_xor(ss[r], o); }
#pragma unroll
        for (int r = 0; r < 8; ++r) { if (r == 0 || m + r * NGW < T) { const float rstd = 1.0f / sqrtf(ss[r] * (1.f / D) + EPS); v2u* o8 = (v2u*)(H + (size_t)rowi[r] * D) + lane;
#pragma unroll
            for (int j = 0; j < 4; ++j) { v2u w; w.x = pk2(v[r][j].x * rstd * gv[j].x, v[r][j].y * rstd * gv[j].y); w.y = pk2(v[r][j].z * rstd * gv[j].z, v[r][j].w * rstd * gv[j].w); o8[64 * j] = w; } } }
    }
}
__device__ __forceinline__ void norm_rows_f32(float* x, const float* g, int wave, int lane, const int TID, const int BID) {
    const int gw = BID * NWAVES + wave, NGW = gridDim.x * NWAVES;
    f32x4 gv[4];
#pragma unroll
    for (int j = 0; j < 4; ++j) gv[j] = ((const f32x4*)g)[lane + 64 * j];
    for (int m = gw; m < T; m += 8 * NGW) {
        f32x4 v[8][4]; float ss[8]; int rowi[8];
#pragma unroll
        for (int r = 0; r < 8; ++r) { const int mr = m + r * NGW; rowi[r] = mr < T ? mr : m; const f32x4* xr = (const f32x4*)(x + (size_t)rowi[r] * D) + lane;
#pragma unroll
            for (int j = 0; j < 4; ++j) v[r][j] = xr[64 * j]; }
#pragma unroll
        for (int r = 0; r < 8; ++r) { float s = 0.f;
#pragma unroll
            for (int j = 0; j < 4; ++j) s += (v[r][j].x * v[r][j].x + v[r][j].y * v[r][j].y) + (v[r][j].z * v[r][j].z + v[r][j].w * v[r][j].w);
            ss[r] = s; }
#pragma unroll
        for (int o = 1; o < 64; o <<= 1) {
#pragma unroll
            for (int r = 0; r < 8; ++r) ss[r] += __shfl_xor(ss[r], o); }
#pragma unroll
        for (int r = 0; r < 8; ++r) { if (r == 0 || m + r * NGW < T) { const float rstd = 1.0f / sqrtf(ss[r] * (1.f / D) + EPS); f32x4* xr = (f32x4*)(x + (size_t)rowi[r] * D) + lane;
#pragma unroll
            for (int j = 0; j < 4; ++j) xr[64 * j] = v[r][j] * rstd * gv[j]; } }
    }
}
__device__ __forceinline__ void convert_p(const float* p, bf16* pb, const int TID, const int BID) {
    const int n4 = T * PLE / 4, stride = gridDim.x * NTHREADS;
    for (int i = BID * NTHREADS + TID; i < n4; i += 8 * stride) {
        f32x4 v[8];
#pragma unroll
        for (int r = 0; r < 8; ++r) { const int ir = i + r * stride; v[r] = ((const f32x4*)p)[ir < n4 ? ir : i]; }
#pragma unroll
        for (int r = 0; r < 8; ++r) { const int ir = i + r * stride; if (ir < n4) { v2u w; w.x = pk2(v[r].x, v[r].y); w.y = pk2(v[r].z, v[r].w); ((v2u*)pb)[ir] = w; } }
    }
}
#define RLX_AGENT __ATOMIC_RELAXED, __HIP_MEMORY_SCOPE_AGENT
#define XB_TMO      128
#define XB_XCNT(j)  (256  + 64 * (j))
#define XB_XSUB(j)  (1280 + 64 * (j))
#define XB_XGEN(j)  (2304 + 64 * (j))
#define XB_TOP      3328
#define XB_TOPGEN   3392
#define XCD_BAR_WORDS 3456
#define XB_SPIN_CAP (1u << 18)

__device__ __forceinline__ unsigned xb_ld(unsigned* p)              { return __hip_atomic_load(p, __ATOMIC_RELAXED, __HIP_MEMORY_SCOPE_AGENT); }
__device__ __forceinline__ unsigned xb_add(unsigned* p, unsigned v) { return __hip_atomic_fetch_add(p, v, __ATOMIC_RELAXED, __HIP_MEMORY_SCOPE_AGENT); }
__device__ __forceinline__ unsigned xb_xcc_id() { return (unsigned)__builtin_amdgcn_s_getreg((3 << 11) | 20) & 0xFu; }
#define XB_SPIN(cond, bar) do { unsigned _sp = 0; while (cond) { __builtin_amdgcn_s_sleep(1); \
    if ((++_sp & 255u) == 0u) { if (xb_ld(&(bar)[XB_TMO])) break; if (_sp > XB_SPIN_CAP) { atomicAdd(&(bar)[XB_TMO], 1u); break; } } } } while (0)

struct XcdBarrier {
    unsigned* bar; unsigned x;
    volatile LAS unsigned* st;
};

__device__ __forceinline__ XcdBarrier xcd_barrier_post(unsigned* bar, volatile LAS unsigned* st) {
    XcdBarrier b; b.bar = bar; b.x = xb_xcc_id(); b.st = st;
    if (threadIdx.x == 0) (void)xb_add(&bar[XB_XCNT(b.x)], 1u);
    return b;
}
__device__ __forceinline__ void xcd_barrier_complete(unsigned* bar, unsigned x, unsigned& nloc, unsigned& nx) {
    const unsigned G = gridDim.x * gridDim.y * gridDim.z;
    unsigned sum, cnt, mine, sp = 0u;
    for (;;) {
        sum = 0u; cnt = 0u; mine = 0u;
#pragma unroll
        for (unsigned j = 0; j < 16; ++j) { const unsigned c = xb_ld(&bar[XB_XCNT(j)]); sum += c; cnt += (c > 0u) ? 1u : 0u; mine = (j == x) ? c : mine; }
        if (sum == G) break;
        __builtin_amdgcn_s_sleep(1);
        if ((++sp & 255u) == 0u) { if (xb_ld(&bar[XB_TMO])) break; if (sp > XB_SPIN_CAP) { atomicAdd(&bar[XB_TMO], 1u); break; } }
    }
    nloc = mine > 0u ? mine : 1u; nx = cnt > 0u ? cnt : 1u;
}

__device__ __forceinline__ void xcd_barrier(const XcdBarrier& b) {
    asm volatile("s_waitcnt vmcnt(0)" ::: "memory");
    __syncthreads();
    if (threadIdx.x == 0) {
        unsigned* bar = b.bar;
        __builtin_amdgcn_s_waitcnt(0);
        unsigned nloc = b.st[0], nx = b.st[1];
        if (nloc == 0u) { xcd_barrier_complete(bar, b.x, nloc, nx); b.st[0] = nloc; b.st[1] = nx; }
        const unsigned old = xb_add(&bar[XB_XSUB(b.x)], 1u);
        const unsigned gen = old / nloc;
        if (old + 1u == (gen + 1u) * nloc) {
            __builtin_amdgcn_fence(__ATOMIC_RELEASE, "agent");
            asm volatile("s_waitcnt vmcnt(0)" ::: "memory");
            const unsigned og = xb_add(&bar[XB_TOP], 1u);
            const unsigned tg = og / nx;
            if (og + 1u == (tg + 1u) * nx) xb_add(&bar[XB_TOPGEN], 1u);
            else XB_SPIN(xb_ld(&bar[XB_TOPGEN]) == tg, bar);
            __builtin_amdgcn_fence(__ATOMIC_ACQUIRE, "agent");
            xb_add(&bar[XB_XGEN(b.x)], 1u);
            asm volatile("s_waitcnt vmcnt(0)" ::: "memory");
        } else {
            XB_SPIN(xb_ld(&bar[XB_XGEN(b.x)]) == gen, bar);
            __builtin_amdgcn_fence(__ATOMIC_ACQUIRE, "agent");
            asm volatile("s_waitcnt vmcnt(0)" ::: "memory");
        }
    }
    __syncthreads();
}
constexpr int GL_BS = 0, GL_SEG = 16640, GL_X0 = 18688, GL_X1 = GL_X0 + 9216, GL_X2 = GL_X1 + 9216, GL_Y0 = GL_X2 + 9216, GL_VS = GL_Y0 + 18432, GL_OS = GL_VS + 20480, GL_END = GL_OS + 64 * 132 * 4;
constexpr int GL_KS = GL_X0;
constexpr int VSP = 320, KSP = 192;
static_assert(GL_END <= RING_BYTES && GL_KS + 64 * KSP <= GL_Y0, "GLA LDS");
typedef short gv4i16 __attribute__((ext_vector_type(4)));
__device__ __forceinline__ bf16x8 tr_frag(LAS unsigned char* img, int pitch, int k0, int n0, int lane) {
    const int tq = (lane >> 2) & 3, tp = lane & 3;
    LAS unsigned char* a = img + (k0 + tq) * pitch + (n0 + 4 * tp) * 2;
    const gv4i16 lo = __builtin_amdgcn_ds_read_tr16_b64_v4i16((LAS gv4i16*)a), hi = __builtin_amdgcn_ds_read_tr16_b64_v4i16((LAS gv4i16*)(a + 4 * pitch));
    return (bf16x8){lo[0], lo[1], lo[2], lo[3], hi[0], hi[1], hi[2], hi[3]};
}
constexpr int LP = 72;
__device__ __forceinline__ void gla_cumdecay(const bf16* z, size_t row0, int h, const float* w2, const float* bias, LAS unsigned char* lds, const int TID) {
    LAS float* bS = (LAS float*)(lds + GL_BS); LAS float* seg = (LAS float*)(lds + GL_SEG);
    const int tid = TID, d = tid & 63, sg = tid >> 6;
    float w[16];
#pragma unroll
    for (int r = 0; r < 16; ++r) w[r] = w2[r * 256 + h * 64 + d];
    const float bb = bias[h * 64 + d];
    float run = 0.f;
#pragma unroll
    for (int i = 0; i < 8; ++i) { const int s = 8 * sg + i; const v4u* gp = (const v4u*)(z + (row0 + s) * ZS + C_GA); const v4u g0 = gp[0], g1 = gp[1];
        float a = bb;
        a += bflo(g0.x) * w[0] + bfhi(g0.x) * w[1] + bflo(g0.y) * w[2] + bfhi(g0.y) * w[3] + bflo(g0.z) * w[4] + bfhi(g0.z) * w[5] + bflo(g0.w) * w[6] + bfhi(g0.w) * w[7];
        a += bflo(g1.x) * w[8] + bfhi(g1.x) * w[9] + bflo(g1.y) * w[10] + bfhi(g1.y) * w[11] + bflo(g1.z) * w[12] + bfhi(g1.z) * w[13] + bflo(g1.w) * w[14] + bfhi(g1.w) * w[15];
        const float ls = fminf(a, 0.f) - __logf(1.0f + __expf(-fabsf(a)));
        run += ls * (1.0f / 16.0f); bS[s * 65 + d] = run; }
    seg[sg * 64 + d] = run;
    __syncthreads();
    float off = 0.f;
#pragma unroll
    for (int j = 0; j < 8; ++j) if (j < sg) off += seg[j * 64 + d];
#pragma unroll
    for (int i = 0; i < 8; ++i) { const int s = 8 * sg + i; bS[s * 65 + d] += off; }
    __syncthreads();
}
__device__ __forceinline__ void gla_stage_v(const bf16* z, size_t row0, int h, LAS unsigned char* vS, const int TID) {
    const int tid = TID, s = tid >> 3, eg = tid & 7;
    const v4u* vp = (const v4u*)(z + (row0 + s) * ZS + C_GV + h * 128 + 16 * eg); const v4u a = vp[0], b = vp[1];
    *(LAS v4u*)(vS + s * VSP + eg * 32) = a; *(LAS v4u*)(vS + s * VSP + eg * 32 + 16) = b;
}
__device__ __forceinline__ void gla_local_item(const bf16* z, int item, const float* w2, const float* bias, float* dS, float* Adec, LAS unsigned char* lds, const int TID) {
    const int c = item & 127, h = (item >> 7) & 3, b = item >> 9; const size_t row0 = (size_t)b * SEQ + c * 64;
    gla_cumdecay(z, row0, h, w2, bias, lds, TID);
    LAS float* bS = (LAS float*)(lds + GL_BS); LAS unsigned char* ksS = lds + GL_KS; LAS unsigned char* vS = lds + GL_VS;
    const int tid = TID, lane = tid & 63, wave = tid >> 6;
    { const int s = tid >> 3, dg = tid & 7; const v4u kw = *(const v4u*)(z + (row0 + s) * ZS + C_GK + h * 64 + 8 * dg);
      const unsigned w[4] = {kw.x, kw.y, kw.z, kw.w}; unsigned o[4];
#pragma unroll
      for (int j = 0; j < 4; ++j) { const int d0 = 8 * dg + 2 * j;
          o[j] = pk2(bflo(w[j]) * __expf(bS[63 * 65 + d0] - bS[s * 65 + d0]), bfhi(w[j]) * __expf(bS[63 * 65 + d0 + 1] - bS[s * 65 + d0 + 1])); }
      *(LAS v4u*)(ksS + s * KSP + dg * 16) = (v4u){o[0], o[1], o[2], o[3]}; }
    gla_stage_v(z, row0, h, vS, TID);
    if (tid < 64) Adec[(size_t)item * 64 + tid] = expf(bS[63 * 65 + tid]);
    __syncthreads();
    { const int te = wave >> 1, td = wave & 1, l32 = lane & 31, hl = lane >> 5, tg = (lane >> 4) & 1; f32x16 acc = {};
#pragma unroll
      for (int ks = 0; ks < 4; ++ks) { const bf16x8 av = tr_frag(vS, VSP, 16 * ks + 8 * hl, 32 * te + 16 * tg, lane); const bf16x8 bv = tr_frag(ksS, KSP, 16 * ks + 8 * hl, 32 * td + 16 * tg, lane);
          acc = __builtin_amdgcn_mfma_f32_32x32x16_bf16(av, bv, acc, 0, 0, 0); }
      float* o = dS + (size_t)item * 8192;
#pragma unroll
      for (int r = 0; r < 16; ++r) { const int e = 32 * te + 8 * (r >> 2) + 4 * hl + (r & 3), d = 32 * td + l32; o[e * 64 + d] = acc[r]; } }
    __syncthreads();
}
__device__ __forceinline__ void gla_scan(float* dS, const float* Adec, const int TID, const int BID) {
    if (TID >= 256) return;
    const int gid = BID * 256 + TID;
    if (gid >= 8 * 8192) return;
    const int bh = gid >> 13, i = gid & 8191, d = i & 63;
    float st = 0.f; float* p = dS + (size_t)bh * 128 * 8192 + i; const float* ap = Adec + (size_t)bh * 128 * 64 + d;
    for (int c0 = 0; c0 < 128; c0 += 64) {
        float tv[64], av[64];
#pragma unroll
        for (int j = 0; j < 64; ++j) { tv[j] = p[(size_t)(c0 + j) * 8192]; av[j] = ap[(c0 + j) * 64]; }
#pragma unroll
        for (int j = 0; j < 64; ++j) { p[(size_t)(c0 + j) * 8192] = st; st = av[j] * st + tv[j]; }
    }
}
__device__ __forceinline__ void gla_out_item(bf16* z, int item, const float* w2, const float* bias, const float* gnorm, const float* Sin, LAS unsigned char* lds, const int TID) {
    const int c = item & 127, h = (item >> 7) & 3, b = item >> 9; const size_t row0 = (size_t)b * SEQ + c * 64;
    gla_cumdecay(z, row0, h, w2, bias, lds, TID);
    LAS float* bS = (LAS float*)(lds + GL_BS); LAS bf16* qe = (LAS bf16*)(lds + GL_X0); LAS bf16* ke = (LAS bf16*)(lds + GL_X1); LAS bf16* at = (LAS bf16*)(lds + GL_X2);
    LAS bf16* STb = (LAS bf16*)(lds + GL_Y0); LAS unsigned char* vS = lds + GL_VS; LAS float* oS = (LAS float*)(lds + GL_OS);
    const int tid = TID, lane = tid & 63, wave = tid >> 6, l32 = lane & 31, hl = lane >> 5;
    { const int s = tid >> 3, dg = tid & 7; const v4u qw = *(const v4u*)(z + (row0 + s) * ZS + C_GQ + h * 64 + 8 * dg); const v4u kw = *(const v4u*)(z + (row0 + s) * ZS + C_GK + h * 64 + 8 * dg);
      const unsigned wq[4] = {qw.x, qw.y, qw.z, qw.w}, wk[4] = {kw.x, kw.y, kw.z, kw.w}; unsigned oq[4], ok[4];
#pragma unroll
      for (int j = 0; j < 4; ++j) { const int d0 = 8 * dg + 2 * j; const float b0 = bS[s * 65 + d0], b1 = bS[s * 65 + d0 + 1]; const float e0 = __expf(b0), e1 = __expf(b1);
          oq[j] = pk2(bflo(wq[j]) * 0.125f * e0, bfhi(wq[j]) * 0.125f * e1); ok[j] = pk2(bflo(wk[j]) / e0, bfhi(wk[j]) / e1); }
      *(LAS v4u*)(qe + s * LP + 8 * dg) = (v4u){oq[0], oq[1], oq[2], oq[3]}; *(LAS v4u*)(ke + s * LP + 8 * dg) = (v4u){ok[0], ok[1], ok[2], ok[3]}; }
    { const int e = tid >> 2, dq = tid & 3; const f32x4* sp = (const f32x4*)(Sin + (size_t)item * 8192 + e * 64 + 16 * dq); const f32x4 s0 = sp[0], s1 = sp[1], s2 = sp[2], s3 = sp[3];
      *(LAS v4u*)(STb + e * LP + 16 * dq) = (v4u){pk2(s0.x, s0.y), pk2(s0.z, s0.w), pk2(s1.x, s1.y), pk2(s1.z, s1.w)};
      *(LAS v4u*)(STb + e * LP + 16 * dq + 8) = (v4u){pk2(s2.x, s2.y), pk2(s2.z, s2.w), pk2(s3.x, s3.y), pk2(s3.z, s3.w)}; }
    gla_stage_v(z, row0, h, vS, TID);
    __syncthreads();
    if (wave < 4) { const int tt = wave >> 1, ts = wave & 1; f32x16 acc = {};
#pragma unroll
      for (int ks = 0; ks < 4; ++ks) { const bf16x8 av = *(const LAS bf16x8*)(qe + (32 * tt + l32) * LP + 16 * ks + 8 * hl); const bf16x8 bv = *(const LAS bf16x8*)(ke + (32 * ts + l32) * LP + 16 * ks + 8 * hl);
          acc = __builtin_amdgcn_mfma_f32_32x32x16_bf16(av, bv, acc, 0, 0, 0); }
#pragma unroll
      for (int r = 0; r < 16; ++r) { const int t = 32 * tt + 8 * (r >> 2) + 4 * hl + (r & 3), s = 32 * ts + l32; at[t * LP + s] = (bf16)f2bf(s <= t ? acc[r] : 0.f); } }
    __syncthreads();
    { const int tt = wave >> 2, te = wave & 3; f32x16 acc = {};
#pragma unroll
      for (int ks = 0; ks < 4; ++ks) { const bf16x8 av = *(const LAS bf16x8*)(qe + (32 * tt + l32) * LP + 16 * ks + 8 * hl); const bf16x8 bv = *(const LAS bf16x8*)(STb + (32 * te + l32) * LP + 16 * ks + 8 * hl);
          acc = __builtin_amdgcn_mfma_f32_32x32x16_bf16(av, bv, acc, 0, 0, 0); }
#pragma unroll
      for (int ks = 0; ks < 4; ++ks) { const bf16x8 av = *(const LAS bf16x8*)(at + (32 * tt + l32) * LP + 16 * ks + 8 * hl); const bf16x8 bv = tr_frag(vS, VSP, 16 * ks + 8 * hl, 32 * te + 16 * ((lane >> 4) & 1), lane);
          acc = __builtin_amdgcn_mfma_f32_32x32x16_bf16(av, bv, acc, 0, 0, 0); }
#pragma unroll
      for (int r = 0; r < 16; ++r) { const int t = 32 * tt + 8 * (r >> 2) + 4 * hl + (r & 3), e = 32 * te + l32; oS[t * 132 + e] = acc[r]; } }
    __syncthreads();
    { const int t = tid >> 3, eg = tid & 7; float o[16]; float ss = 0.f;
#pragma unroll
      for (int j = 0; j < 4; ++j) { const f32x4 v = *(const LAS f32x4*)(oS + t * 132 + 16 * eg + 4 * j); o[4 * j] = v.x; o[4 * j + 1] = v.y; o[4 * j + 2] = v.z; o[4 * j + 3] = v.w; ss += (v.x * v.x + v.y * v.y) + (v.z * v.z + v.w * v.w); }
      ss += __shfl_xor(ss, 1); ss += __shfl_xor(ss, 2); ss += __shfl_xor(ss, 4);
      const float rstd = 1.0f / sqrtf(ss * (1.0f / 128.0f) + EPS);
      const v4u* gp = (const v4u*)(z + (row0 + t) * ZS + C_GR + h * 128 + 16 * eg); const v4u g0 = gp[0], g1 = gp[1]; const unsigned gw[8] = {g0.x, g0.y, g0.z, g0.w, g1.x, g1.y, g1.z, g1.w};
      unsigned ow[8];
#pragma unroll
      for (int j = 0; j < 8; ++j) { const float ga = bflo(gw[j]), gb = bfhi(gw[j]); const float sa = ga / (1.0f + __expf(-ga)), sb = gb / (1.0f + __expf(-gb));
          ow[j] = pk2(o[2 * j] * rstd * gnorm[16 * eg + 2 * j] * sa, o[2 * j + 1] * rstd * gnorm[16 * eg + 2 * j + 1] * sb); }
      v4u* op = (v4u*)(z + (row0 + t) * ZS + C_GV + h * 128 + 16 * eg); op[0] = (v4u){ow[0], ow[1], ow[2], ow[3]}; op[1] = (v4u){ow[4], ow[5], ow[6], ow[7]}; }
    __syncthreads();
}
constexpr int DS_SEL = 0, DS_CI = 2048, DS_CV = 2048, DS_LG = 10240;
constexpr int NBIN = 1024, TOPK = 256;
constexpr int KST_OFF = LDSCTL_OFF + 2048;
#define GLD16(dst, ptr) asm volatile("global_load_dwordx4 %0, %1, off" : "=&v"(dst) : "v"(ptr) : "memory")
#define GLD8(dst, ptr) asm volatile("global_load_dwordx2 %0, %1, off" : "=&v"(dst) : "v"(ptr) : "memory")
#define VM_WAIT(n, reg) asm volatile("s_waitcnt vmcnt(" #n ")" : "+v"(reg) : : "memory")
#define LDS_BAR() do { asm volatile("s_waitcnt lgkmcnt(0)" ::: "memory"); __builtin_amdgcn_s_barrier(); asm volatile("" ::: "memory"); } while (0)
__device__ __forceinline__ unsigned kswz(int key, int c) { return (unsigned)(key * 128 + ((c ^ ((key >> 1) & 7)) << 4)); }
__device__ __forceinline__ unsigned vrow(int key, int c) { return (unsigned)(key * 128 + ((c ^ (((key >> 1) & 1) << 2)) << 4)); }
typedef short v4i16_t __attribute__((ext_vector_type(4)));
__device__ __forceinline__ int score_bin(float v) {
    unsigned u = __float_as_uint(v); if (u == 0x80000000u) u = 0u;
    int k = (int)((u & 0x7fffffffu) >> 19) - (103 << 4);
    k = k < 0 ? 0 : (k > 511 ? 511 : k);
    return (u >> 31) ? (511 - k) : (512 + k);
}
__device__ __forceinline__ float relu_(float x) { const int i = __float_as_int(x); return __int_as_float(i > 0 ? i : 0); }
template <int PASS> __device__ __forceinline__ void idx_epilogue(const f32x16& accA, const f32x16& accB, int st, int lane, int l32, int hl, const float (&wq)[2][8], int b1l0, int b1l1,
                                                                 LAS unsigned* hist, int (&cc)[2], LAS unsigned long long* cand, LAS unsigned* mk) {
#pragma unroll
    for (int half = 0; half < 2; ++half) {
#pragma unroll
        for (int qq = 0; qq < 2; ++qq) { float I = 0.f;
#pragma unroll
            for (int h = 0; h < 8; ++h) I = __builtin_fmaf(wq[qq][h], relu_(half ? accB[8 * qq + h] : accA[8 * qq + h]), I);
            const int bin = score_bin(I); const int q = 2 * hl + qq;
            if (PASS == 1) { __hip_atomic_fetch_add(hist + q * 1024 + bin, 1u, __ATOMIC_RELAXED, __HIP_MEMORY_SCOPE_WORKGROUP); }
            else { const int bq = qq ? b1l1 : b1l0;
                const unsigned long long ms = __ballot(bin > bq);
                if (l32 == 0) mk[q * 256 + 2 * st + half] = hl ? (unsigned)(ms >> 32) : (unsigned)ms;
                const bool isCand = bin == bq; const unsigned long long mc = __ballot(isCand);
                if (mc) { const unsigned mine = hl ? (unsigned)(mc >> 32) : (unsigned)mc;
                    if (isCand) { const unsigned pos = (unsigned)cc[qq] + __builtin_popcount(mine & ((1u << l32) - 1u));
                        if (pos < 256u) { unsigned ub = __float_as_uint(I); if (ub == 0x80000000u) ub = 0u; ub = (ub >> 31) ? ~ub : (ub | 0x80000000u); cand[q * 256 + pos] = ((unsigned long long)ub << 32) | (unsigned long long)(0xffffu - (unsigned)(64 * st + 32 * half + l32)); } }
                    cc[qq] += __builtin_popcount(mine); } } }
    }
}
template <int PASS> __device__ __forceinline__ void idx_pass(const bf16* z, size_t rowb, int nst, LAS unsigned char* lds, const bf16x8 (&qa)[4], const float (&wq)[2][8], int b1l0, int b1l1,
                                                             LAS unsigned* hist, int (&cc)[2], LAS unsigned long long* cand, LAS unsigned* mk, const int TID) {
    const int lane = TID & 63, l32 = lane & 31, hl = lane >> 5;
    const int skey = 8 * (TID >> 6) + (TID & 7), sc = (TID >> 3) & 7;
    const bf16* gp = z + (rowb + skey) * ZS + C_IK + 8 * sc;
    LAS unsigned char* kst = lds + KST_OFF;
    const unsigned wofs = (unsigned)(((skey >> 5) * 4 + (sc >> 1)) * 1024 + ((sc & 1) * 32 + (skey & 31)) * 16);
    unsigned roA[4], roB[4];
#pragma unroll
    for (int ks = 0; ks < 4; ++ks) { roA[ks] = (unsigned)(ks * 1024 + lane * 16); roB[ks] = (unsigned)((4 + ks) * 1024 + lane * 16); }
    const int last = nst - 1;
#define IDX_LD(slot, stg) do { const int s_ = (stg) < last ? (stg) : last; GLD16(pre[slot], gp + (size_t)s_ * 64 * ZS); } while (0)
    v4u pre[4];
    asm volatile("s_waitcnt vmcnt(0)" ::: "memory");
#pragma unroll
    for (int i = 0; i < 4; ++i) IDX_LD(i, i);
    VM_WAIT(3, pre[0]);
    *(LAS v4u*)(kst + wofs) = pre[0];
    IDX_LD(0, 4);
    LDS_BAR();
    for (int st0 = 0; st0 < nst; st0 += 4) {
#pragma unroll
        for (int i = 0; i < 4; ++i) { const int st = st0 + i; if (st < nst) {
            LAS unsigned char* cur = kst + (i & 1) * 8192;
            f32x16 accA = {}, accB = {};
            { bf16x8 ka[4], kb[4];
#pragma unroll
              for (int ks = 0; ks < 4; ++ks) { ka[ks] = *(const LAS bf16x8*)(cur + roA[ks]); kb[ks] = *(const LAS bf16x8*)(cur + roB[ks]); }
              __builtin_amdgcn_sched_barrier(0);
#pragma unroll
              for (int ks = 0; ks < 4; ++ks) { accA = __builtin_amdgcn_mfma_f32_32x32x16_bf16(qa[ks], ka[ks], accA, 0, 0, 0); accB = __builtin_amdgcn_mfma_f32_32x32x16_bf16(qa[ks], kb[ks], accB, 0, 0, 0); } }
            VM_WAIT(3, pre[(i + 1) & 3]);
            *(LAS v4u*)(kst + ((i + 1) & 1) * 8192 + wofs) = pre[(i + 1) & 3]; IDX_LD((i + 1) & 3, st + 5);
            idx_epilogue<PASS>(accA, accB, st, lane, l32, hl, wq, b1l0, b1l1, hist, cc, cand, mk);
            LDS_BAR();
        } }
    }
#undef IDX_LD
    asm volatile("s_waitcnt vmcnt(0)" ::: "memory");
}
__device__ __forceinline__ void dsa_select_item(const bf16* z, unsigned* mask, int b, int qt, LAS unsigned char* lds, const int TID) {
    const int lane = TID & 63, wave = __builtin_amdgcn_readfirstlane(TID >> 6), l32 = lane & 31, hl = lane >> 5;
    LAS unsigned char* R = lds + wave * 16384;
    LAS unsigned* hist = (LAS unsigned*)R;
    const size_t rowb = (size_t)b * SEQ; const int t0 = 32 * qt + 4 * wave; const int nadm = 64 * ((qt >> 1) + 1);
    LAS unsigned long long* cand = (LAS unsigned long long*)(R + DS_CV); LAS unsigned* mk = (LAS unsigned*)(R + DS_LG);
    if (nadm > TOPK) {
        bf16x8 qa[4];
        { const int i = l32, ql = 2 * ((i >> 2) & 1) + (i >> 4), hd = 4 * ((i >> 3) & 1) + (i & 3);
          const bf16* qp = z + (rowb + t0 + ql) * ZS + C_IQ + hd * 64 + 8 * hl;
#pragma unroll
          for (int ks = 0; ks < 4; ++ks) qa[ks] = *(const bf16x8*)(qp + 16 * ks); }
        float wq[2][8];
#pragma unroll
        for (int qq = 0; qq < 2; ++qq) { const v4u ww = *(const v4u*)(z + (rowb + t0 + 2 * hl + qq) * ZS + C_IW); const float sc = 0.044194173824159216f;
            wq[qq][0] = bflo(ww.x) * sc; wq[qq][1] = bfhi(ww.x) * sc; wq[qq][2] = bflo(ww.y) * sc; wq[qq][3] = bfhi(ww.y) * sc; wq[qq][4] = bflo(ww.z) * sc; wq[qq][5] = bfhi(ww.z) * sc; wq[qq][6] = bflo(ww.w) * sc; wq[qq][7] = bfhi(ww.w) * sc; }
        for (int i = lane; i < 1024; i += 64) *(LAS v4u*)(R + i * 16) = (v4u){0u, 0u, 0u, 0u};
        LDS_FENCE();
        int cc[2] = {0, 0};
        idx_pass<1>(z, rowb, nadm >> 6, lds, qa, wq, 0, 0, hist, cc, cand, mk, TID);
        LDS_FENCE();
        int b1[4], cab[4];
        { int tot[4], incl[4];
#pragma unroll
          for (int q = 0; q < 4; ++q) { const LAS v4u* hp = (const LAS v4u*)(hist + q * 1024 + 1008 - 16 * lane); const v4u a = hp[0], bb = hp[1], c = hp[2], d = hp[3];
              tot[q] = (int)((a.x + a.y + a.z + a.w) + (bb.x + bb.y + bb.z + bb.w) + (c.x + c.y + c.z + c.w) + (d.x + d.y + d.z + d.w)); incl[q] = tot[q]; }
#pragma unroll
          for (int o = 1; o < 64; o <<= 1) {
#pragma unroll
              for (int q = 0; q < 4; ++q) { const int tv = __shfl_up(incl[q], o); if (lane >= o) incl[q] += tv; } }
#pragma unroll
          for (int q = 0; q < 4; ++q) { const unsigned long long mkb = __ballot(incl[q] >= TOPK); const int F = __builtin_ctzll(mkb);
              int cum = __builtin_amdgcn_readfirstlane(__shfl(incl[q] - tot[q], F));
              const int base = 1008 - 16 * F; const LAS v4u* hp = (const LAS v4u*)(hist + q * 1024 + base); const v4u a = hp[0], bb = hp[1], c = hp[2], d = hp[3];
              const unsigned v[16] = {a.x, a.y, a.z, a.w, bb.x, bb.y, bb.z, bb.w, c.x, c.y, c.z, c.w, d.x, d.y, d.z, d.w};
              int bq = base, cq = cum; bool found = false;
#pragma unroll
              for (int j = 15; j >= 0; --j) { const int nxt = cum + (int)v[j]; if (!found && nxt >= TOPK) { bq = base + j; cq = cum; found = true; } cum = nxt; }
              b1[q] = __builtin_amdgcn_readfirstlane(bq); cab[q] = __builtin_amdgcn_readfirstlane(cq); } }
        LDS_FENCE();
        idx_pass<2>(z, rowb, nadm >> 6, lds, qa, wq, hl ? b1[2] : b1[0], hl ? b1[3] : b1[1], hist, cc, cand, mk, TID);
        LDS_FENCE();
        const int nc0 = __builtin_amdgcn_readfirstlane(__shfl(cc[0], 0)), nc1 = __builtin_amdgcn_readfirstlane(__shfl(cc[1], 0)), nc2 = __builtin_amdgcn_readfirstlane(__shfl(cc[0], 32)), nc3 = __builtin_amdgcn_readfirstlane(__shfl(cc[1], 32));
#pragma unroll
        for (int q = 0; q < 4; ++q) { const int ncr = q == 0 ? nc0 : (q == 1 ? nc1 : (q == 2 ? nc2 : nc3)); const int nc = min(ncr, 256); const int need = TOPK - cab[q];
            const LAS unsigned long long* ck = cand + q * 256;
            unsigned long long mine[4]; int rank[4];
#pragma unroll
            for (int c = 0; c < 4; ++c) { mine[c] = (lane + 64 * c < nc) ? ck[lane + 64 * c] : ~0ull; rank[c] = 0; }
#pragma unroll 8
            for (int j = 0; j < nc; ++j) { const unsigned long long kj = ck[j];
#pragma unroll
                for (int c = 0; c < 4; ++c) rank[c] += (kj > mine[c]) ? 1 : 0; }
#pragma unroll
            for (int c = 0; c < 4; ++c) if (lane + 64 * c < nc && rank[c] < need) { const unsigned key = 0xffffu - (unsigned)(mine[c] & 0xffffull); __hip_atomic_fetch_or(mk + q * 256 + (key >> 5), 1u << (key & 31), __ATOMIC_RELAXED, __HIP_MEMORY_SCOPE_WORKGROUP); }
        }
        LDS_FENCE();
    } else {
        for (int i = lane; i < 256; i += 64) *(LAS v4u*)(R + DS_LG + i * 16) = (v4u){0u, 0u, 0u, 0u};
        LDS_FENCE();
#pragma unroll
        for (int q = 0; q < 4; ++q) for (int w = lane; w < (nadm >> 5); w += 64) mk[q * 256 + w] = 0xffffffffu;
        LDS_FENCE();
    }
#pragma unroll
    for (int q = 0; q < 4; ++q) ((v4u*)(mask + (rowb + t0 + q) * 256))[lane] = *(const LAS v4u*)(mk + q * 256 + 4 * lane);
    LDS_FENCE();
}
constexpr int AT_K = 0, AT_V = 16384;
__device__ __forceinline__ unsigned pk2t(float lo, float hi) { unsigned r; asm volatile("v_cvt_pk_bf16_f32 %0, %1, %2" : "=v"(r) : "v"(lo), "v"(hi)); return r; }
__device__ __forceinline__ void attn_unit(const bf16* z, bf16* O, int opitch, const unsigned* mask, int b, int h, int qb, LAS unsigned char* lds, const int TID) {
    const int lane = TID & 63, wave = __builtin_amdgcn_readfirstlane(TID >> 6), l32 = lane & 31, hl = lane >> 5;
    const size_t rowb = (size_t)b * SEQ; const int myq = 256 * qb + 32 * wave + l32; const int cw = 4 * qb + (wave >> 1), nt = 4 * qb + 4;
    bf16x8 qf[4];
    { const bf16* qp = z + (rowb + myq) * ZS + C_AQ + h * 64 + 8 * hl;
#pragma unroll
      for (int ks = 0; ks < 4; ++ks) qf[ks] = *(const bf16x8*)(qp + 16 * ks); }
    const unsigned long long* mrow = (const unsigned long long*)(mask + (rowb + myq) * 256);
    const int skey = TID >> 3, sc = TID & 7;
    const bf16* kg = z + (rowb + skey) * ZS + C_AK + h * 64 + 8 * sc; const bf16* vg = z + (rowb + skey) * ZS + C_AV + h * 64 + 8 * sc;
    const unsigned kofs = kswz(skey, sc);
    const unsigned vwofs = vrow(skey, sc);
    const int tq = (lane >> 2) & 3, tp = lane & 3, tg = (lane >> 4) & 1;
    v4u kpre[2], vpre[2]; unsigned long long mwv[2];
#pragma unroll
    for (int i = 0; i < 2; ++i) { kpre[i] = *(const v4u*)(kg + (size_t)i * 64 * ZS); vpre[i] = *(const v4u*)(vg + (size_t)i * 64 * ZS); mwv[i] = mrow[i]; }
#define AT_WRITE(bufsel, sl) do { *(LAS v4u*)(lds + AT_K + (bufsel) * 8192 + kofs) = kpre[sl]; *(LAS v4u*)(lds + AT_V + (bufsel) * 8192 + vwofs) = vpre[sl]; } while (0)
    AT_WRITE(0, 0);
    LDS_BAR();
    f32x16 o0 = {}, o1 = {}; float m = -INFINITY, l = 0.f;
    const float SC = 0.18033688011112042f;
    for (int t0 = 0; t0 < nt; t0 += 2) {
#pragma unroll
        for (int i = 0; i < 2; ++i) { const int t = t0 + i;
            const unsigned long long mw = mwv[i];
            if (t + 2 < nt) { kpre[i] = *(const v4u*)(kg + (size_t)(t + 2) * 64 * ZS); vpre[i] = *(const v4u*)(vg + (size_t)(t + 2) * 64 * ZS); mwv[i] = mrow[t + 2]; }
            if (t <= cw) {
                LAS unsigned char* curK = lds + AT_K + i * 8192; LAS unsigned char* curV = lds + AT_V + i * 8192;
                f32x16 s0 = {}, s1 = {};
                { bf16x8 a0[4], a1[4];
#pragma unroll
                  for (int ks = 0; ks < 4; ++ks) { a0[ks] = *(const LAS bf16x8*)(curK + kswz(l32, 2 * ks + hl)); a1[ks] = *(const LAS bf16x8*)(curK + kswz(32 + l32, 2 * ks + hl)); }
                  __builtin_amdgcn_sched_barrier(0);
#pragma unroll
                  for (int ks = 0; ks < 4; ++ks) { s0 = __builtin_amdgcn_mfma_f32_32x32x16_bf16(a0[ks], qf[ks], s0, 0, 0, 0); s1 = __builtin_amdgcn_mfma_f32_32x32x16_bf16(a1[ks], qf[ks], s1, 0, 0, 0); } }
                __builtin_amdgcn_sched_barrier(0);
                const int mlo = (int)((unsigned)mw >> (4 * hl)), mhi = (int)((unsigned)(mw >> 32) >> (4 * hl));
                float ta = -INFINITY, tb = -INFINITY;
#pragma unroll
                for (int r = 0; r < 16; ++r) { const int bit = (r & 3) + 8 * (r >> 2);
                    const unsigned x0 = (unsigned)__builtin_amdgcn_sbfe(mlo, bit, 1), x1 = (unsigned)__builtin_amdgcn_sbfe(mhi, bit, 1);
                    s0[r] = __uint_as_float((x0 & __float_as_uint(s0[r])) | (~x0 & 0xff800000u)); s1[r] = __uint_as_float((x1 & __float_as_uint(s1[r])) | (~x1 & 0xff800000u));
                    if (r & 1) tb = __builtin_fmaxf(__builtin_fmaxf(tb, s0[r]), s1[r]); else ta = __builtin_fmaxf(__builtin_fmaxf(ta, s0[r]), s1[r]); }
                float tmax = __builtin_fmaxf(ta, tb);
                tmax = __builtin_fmaxf(tmax, __shfl_xor(tmax, 32));
                const float mnew = __builtin_fmaxf(m, tmax); const float mref = (mnew == -INFINITY) ? 0.f : mnew;
                const float alpha = __builtin_amdgcn_exp2f((m - mref) * SC); const float nb = -mref * SC;
                float ps = 0.f;
#pragma unroll
                for (int r = 0; r < 16; ++r) { s0[r] = __builtin_amdgcn_exp2f(__builtin_fmaf(s0[r], SC, nb)); s1[r] = __builtin_amdgcn_exp2f(__builtin_fmaf(s1[r], SC, nb)); ps += s0[r] + s1[r]; }
                l = l * alpha + ps; m = mnew;
                if (__any(alpha != 1.0f)) {
#pragma unroll
                    for (int r = 0; r < 16; ++r) { o0[r] *= alpha; o1[r] *= alpha; } }
                v4u pw[4];
                pw[0] = (v4u){pk2t(s0[0], s0[1]), pk2t(s0[2], s0[3]), pk2t(s0[4], s0[5]), pk2t(s0[6], s0[7])}; pw[1] = (v4u){pk2t(s0[8], s0[9]), pk2t(s0[10], s0[11]), pk2t(s0[12], s0[13]), pk2t(s0[14], s0[15])};
                pw[2] = (v4u){pk2t(s1[0], s1[1]), pk2t(s1[2], s1[3]), pk2t(s1[4], s1[5]), pk2t(s1[6], s1[7])}; pw[3] = (v4u){pk2t(s1[8], s1[9]), pk2t(s1[10], s1[11]), pk2t(s1[12], s1[13]), pk2t(s1[14], s1[15])};
                { v4i16_t va[4][2], vb[4][2];
#pragma unroll
                  for (int s = 0; s < 4; ++s) {
#pragma unroll
                      for (int pc = 0; pc < 2; ++pc) { const int row = 16 * s + 8 * pc + 4 * hl + tq;
                          const int c0 = 2 * tg + (tp >> 1);
                          va[s][pc] = __builtin_amdgcn_ds_read_tr16_b64_v4i16((LAS v4i16_t*)(curV + vrow(row, c0) + 8 * (tp & 1)));
                          vb[s][pc] = __builtin_amdgcn_ds_read_tr16_b64_v4i16((LAS v4i16_t*)(curV + vrow(row, 4 + c0) + 8 * (tp & 1))); } }
                  __builtin_amdgcn_sched_barrier(0);
#pragma unroll
                  for (int s = 0; s < 4; ++s) { const bf16x8 pf = __builtin_bit_cast(bf16x8, pw[s]);
                      const bf16x8 fa = (bf16x8){va[s][0][0], va[s][0][1], va[s][0][2], va[s][0][3], va[s][1][0], va[s][1][1], va[s][1][2], va[s][1][3]};
                      const bf16x8 fb = (bf16x8){vb[s][0][0], vb[s][0][1], vb[s][0][2], vb[s][0][3], vb[s][1][0], vb[s][1][1], vb[s][1][2], vb[s][1][3]};
                      o0 = __builtin_amdgcn_mfma_f32_32x32x16_bf16(fa, pf, o0, 0, 0, 0); o1 = __builtin_amdgcn_mfma_f32_32x32x16_bf16(fb, pf, o1, 0, 0, 0); } }
            }
        if (t + 1 < nt) AT_WRITE((i + 1) & 1, (i + 1) & 1);
            LDS_BAR();
        }
    }
#undef AT_WRITE
    l += __shfl_xor(l, 32);
    const float inv = 1.0f / l;
    bf16* orow = O + (rowb + myq) * opitch + h * 64 + 4 * hl;
#pragma unroll
    for (int g = 0; g < 4; ++g) {
        *(v2u*)(orow + 8 * g) = (v2u){pk2t(o0[4 * g] * inv, o0[4 * g + 1] * inv), pk2t(o0[4 * g + 2] * inv, o0[4 * g + 3] * inv)};
        *(v2u*)(orow + 32 + 8 * g) = (v2u){pk2t(o1[4 * g] * inv, o1[4 * g + 1] * inv), pk2t(o1[4 * g + 2] * inv, o1[4 * g + 3] * inv)}; }
}
#ifndef PHSEQ
#define PHSEQ 0,1,2,3,4,5,6,7,9,10,11,12,13,14,15
#endif
__device__ const unsigned char kPhSeq[] = {PHSEQ};
constexpr int PH_PER_LAYER = (int)sizeof(kPhSeq), PH_FINAL = DEPTH * PH_PER_LAYER, PH_TOTAL = PH_FINAL + 1;
#ifndef PHMASK
#define PHMASK 0x1FFFF
#endif
#ifndef MK_ONE_LAUNCH
#define MK_ONE_LAUNCH 1
#endif
__global__ void __launch_bounds__(NTHREADS, 2) mega_fwd(Args a_) {
    extern __shared__ __attribute__((aligned(16))) unsigned char lds_raw[];
    LAS unsigned char* lds = (LAS unsigned char*)lds_raw;
    const int ph_lo = a_.ph_lo, ph_hi = a_.ph_hi; unsigned char* const ws0 = a_.ws;
    for (int u = threadIdx.x; u < (LDS_BYTES - LDSCTL_OFF) / 4; u += NTHREADS) ((LAS unsigned*)(lds + LDSCTL_OFF))[u] = 0u;
    __syncthreads();
    XcdBarrier bar; bar.bar = (unsigned*)(a_.ws + WS_CTL); bar.x = 0; bar.st = (volatile LAS unsigned*)(lds + LDSCTL_OFF + 1024);
    if (ph_lo > ph_hi) cg::this_grid().sync();
    if (ph_hi - ph_lo > 1) bar = xcd_barrier_post((unsigned*)(a_.ws + WS_CTL), (volatile LAS unsigned*)(lds + LDSCTL_OFF + 1024));
    for (int ph = ph_lo; ph < ph_hi; ++ph) {
        ArgsP ap = (ArgsP)__builtin_amdgcn_kernarg_segment_ptr(); asm volatile("" : "+s"(ap));
        const int G = gridDim.x; unsigned char* ws = ap->ws;
        bf16* Hb = (bf16*)(ws + WS_H); bf16* Z = (bf16*)(ws + WS_Z); float* dS = (float*)(ws + WS_H); float* Adec = (float*)(ws + WS_SMALL);
        float* PPf = (float*)(ws + WS_Z); bf16* PB = (bf16*)(ws + WS_PB); unsigned* MASK = (unsigned*)(ws + WS_MASK); float* PART = (float*)(ws + WS_PART); bf16* XB2 = (bf16*)(ws + WS_XB2);
        float* X = ap->out;
        int TID = threadIdx.x, BID = blockIdx.x; asm volatile("" : "+v"(TID)); asm volatile("" : "+s"(BID));
        const int lane = TID & 63, wave = __builtin_amdgcn_readfirstlane(TID >> 6);
        if (ph == PH_FINAL) { norm_rows_f32(X, ap->in[21], wave, lane, TID, BID); }
        else {
            const int L = ph / PH_PER_LAYER, k = kPhSeq[ph % PH_PER_LAYER];
            const float* xin = (L == 0) ? ap->in[0] : (const float*)X;
            switch (k) {
            case 0: if (PHMASK & (1 << 0)) {
                convert_weights(ap, L, lds, wave, lane, TID, BID);
                norm_rows(xin, ap->in[9] + L * D, Hb, wave, lane, TID, BID);
            } break;
            case 1: if (PHMASK & (1 << 1)) {
                pg8::Gemm g{Hb, (const bf16*)(ws + WB_GU1), T, 2 * FF, D, D, D}; pg8::StaticOrder S; S.init(T, 2 * FF, G, (int)BID);
                pg8::EpiSwiGLU E{Z, FF, nullptr};
                pg8::gemm_phase<pg8::EpiSwiGLU, pg8::StaticOrder, true, true>(lds, g, S, E, TID);
            } break;
            case 2: if (PHMASK & (1 << 2)) {
                pg8::Gemm g{Z, (const bf16*)(ws + WB_D1), T, D, FF, FF, FF}; pg8::StaticOrder S; S.init(T, D, G, (int)BID);
                pg8::EpiResid E{xin, X, D, 0.5f};
                pg8::gemm_phase<pg8::EpiResid, pg8::StaticOrder, true, true>(lds, g, S, E, TID);
            } break;
            case 3: if (PHMASK & (1 << 3)) { norm_rows(X, ap->in[10] + L * D, Hb, wave, lane, TID, BID); } break;
            case 4: if (PHMASK & (1 << 4)) {
                pg8::Gemm g{Hb, (const bf16*)(ws + WB_IN), T, WINP, D, D, D}; pg8::StaticOrder S; S.init(T, WINP, G, (int)BID);
                pg8::EpiBf16Mask E{Z, ZS, WIN, nullptr};
                pg8::gemm_phase<pg8::EpiBf16Mask, pg8::StaticOrder, true, true>(lds, g, S, E, TID);
            } break;
            case 5: if (PHMASK & (1 << 5)) {
                for (int it = BID; it < 1024; it += G) gla_local_item(Z, it, ap->in[3] + L * 16 * 256, ap->in[4] + L * 256, dS, Adec, lds, TID);
                for (int it = BID; it < 512; it += G) { const int b = it >> 8, j = it & 255; const int qt = b ? (255 - j) : j; dsa_select_item(Z, MASK, b, qt, lds, TID); }
            } break;
            case 6: if (PHMASK & (1 << 6)) { gla_scan(dS, Adec, TID, BID); } break;
            case 7: if (PHMASK & (1 << 7)) {
                for (int it = BID; it < 1024; it += G) gla_out_item(Z, it, ap->in[3] + L * 16 * 256, ap->in[4] + L * 256, ap->in[5] + L * 128, dS, lds, TID);
                const int vcu = (G % 8 == 0) ? ((int)BID % 8) * (G / 8) + (int)BID / 8 : (int)BID;
                for (int it = vcu; it < 256; it += G) { const int bh = it >> 4, s = it & 15; attn_unit(Z, Z + C_AQ, ZS, MASK, bh >> 3, bh & 7, s, lds, TID); attn_unit(Z, Z + C_AQ, ZS, MASK, bh >> 3, bh & 7, 31 - s, lds, TID); }
            } break;
            case 8: if (PHMASK & (1 << 8)) {
                const int vcu = (G % 8 == 0) ? ((int)BID % 8) * (G / 8) + (int)BID / 8 : (int)BID;
                for (int it = vcu; it < 256; it += G) { const int bh = it >> 4, s = it & 15; attn_unit(Z, Z + C_AQ, ZS, MASK, bh >> 3, bh & 7, s, lds, TID); attn_unit(Z, Z + C_AQ, ZS, MASK, bh >> 3, bh & 7, 31 - s, lds, TID); }
            } break;
            case 17: {
                for (int it = BID; it < 512; it += G) { const int b = it >> 8, j = it & 255; const int qt = b ? (255 - j) : j; dsa_select_item(Z, MASK, b, qt, lds, TID); }
            } break;
            case 19: {
                bf16* DUM = (bf16*)(ws + WS_ALL);
                for (int it = BID; it < 256; it += G) { const int bh = it >> 4, s = it & 15; attn_unit(Z, DUM, 512, MASK, bh >> 3, bh & 7, s, lds, TID); attn_unit(Z, DUM, 512, MASK, bh >> 3, bh & 7, 31 - s, lds, TID); }
            } break;
            case 9: if (PHMASK & (1 << 9)) {
                { pg8::Gemm g{Z + C_AQ, (const bf16*)(ws + WB_A), T, D, 512, ZS, 512}; pg8::StaticOrder S; S.init(T, D, G, (int)BID);
                  pg8::EpiMerge<0> E{Z + C_MGA, ZS, Hb, D};
                  pg8::gemm_phase<pg8::EpiMerge<0>, pg8::StaticOrder, true, true>(lds, g, S, E, TID); }
                { pg8::Gemm g{Z + C_GV, (const bf16*)(ws + WB_B), T, D, 512, ZS, 512}; pg8::StaticOrder S; S.init(T, D, G, (int)BID);
                  pg8::EpiMerge<1> E{Z + C_MGB, ZS, Hb, D};
                  pg8::gemm_phase<pg8::EpiMerge<1>, pg8::StaticOrder, true, true>(lds, g, S, E, TID); }
            } break;
            case 10: if (PHMASK & (1 << 10)) {
                pg8::Gemm g{Hb, (const bf16*)(ws + WB_O), T, D, D, D, D}; pg8::StaticOrder S; S.init(T, D, G, (int)BID);
                pg8::EpiResid E{X, X, D, 1.0f};
                pg8::gemm_phase<pg8::EpiResid, pg8::StaticOrder, true, true>(lds, g, S, E, TID);
            } break;
            case 11: if (PHMASK & (1 << 11)) { norm_rows(X, ap->in[11] + L * D, Hb, wave, lane, TID, BID); } break;
            case 12: if (PHMASK & (1 << 12)) {
                pg8::Gemm g{Hb, (const bf16*)(ws + WB_GU2), T, 2 * FF, D, D, D}; pg8::StaticOrder S; S.init(T, 2 * FF, G, (int)BID);
                pg8::EpiSwiGLU E{Z, FF, nullptr};
                pg8::gemm_phase<pg8::EpiSwiGLU, pg8::StaticOrder, true, true>(lds, g, S, E, TID);
            } break;
            case 13: if (PHMASK & (1 << 13)) {
                pg8::Gemm g{Z, (const bf16*)(ws + WB_D2), T, D, FF, FF, FF}; pg8::StaticOrder S; S.init(T, D, G, (int)BID);
                pg8::EpiResid E{X, X, D, 0.5f};
                pg8::gemm_phase<pg8::EpiResid, pg8::StaticOrder, true, true>(lds, g, S, E, TID);
            } break;
            case 14: if (PHMASK & (1 << 14)) { norm_rows(X, ap->in[12] + L * D, Hb, wave, lane, TID, BID); convert_p(ap->in[1] + (size_t)L * T * PLE, PB, TID, BID); } break;
            case 15: if (PHMASK & (1 << 15)) {
                pg8::Gemm g{PB, (const bf16*)(ws + WB_PP), T, D, PLE, PLE, PLE}; pg8::StaticOrder S; S.init(T, D, G, (int)BID);
                pg8::EpiF32 E{PPf, D};
                pg8::gemm_phase<pg8::EpiF32, pg8::StaticOrder, true, true>(lds, g, S, E, TID);
                asm volatile("s_waitcnt vmcnt(0)" ::: "memory");
              {
                pg8::Gemm g{Hb, (const bf16*)(ws + WB_PG), T, D, D, D, D}; pg8::StaticOrder S; S.init(T, D, G, (int)BID);
                pg8::EpiPle E{PPf, X, D, nullptr};
                pg8::gemm_phase<pg8::EpiPle, pg8::StaticOrder, true, true>(lds, g, S, E, TID);
              } } break;

            }
        }
        if (ph + 1 < ph_hi) xcd_barrier(bar);
    }
}

extern "C" void kernel_launch(void* const* d_in, const int* in_sizes, int n_in, void* d_out, int out_size, void* d_ws, size_t ws_size, hipStream_t stream) {
    static int grid = 0;
    if (grid == 0) {
        if (n_in != 22 || out_size != T * D || ws_size < WS_ALL) { fprintf(stderr, "kernel_launch: unexpected shapes (n_in %d out %d ws %zu need %zu)\n", n_in, out_size, ws_size, (size_t)WS_END); grid = -1; return; }
        int dev = 0, cus = 0, per_cu = 0;
        hipGetDevice(&dev); hipDeviceGetAttribute(&cus, hipDeviceAttributeMultiprocessorCount, dev);
        if (hipFuncSetAttribute((const void*)mega_fwd, hipFuncAttributeMaxDynamicSharedMemorySize, LDS_BYTES) != hipSuccess) { fprintf(stderr, "kernel_launch: hipFuncSetAttribute failed\n"); grid = -1; return; }
        if (hipOccupancyMaxActiveBlocksPerMultiprocessor(&per_cu, (const void*)mega_fwd, NTHREADS, LDS_BYTES) != hipSuccess || per_cu < 1) { fprintf(stderr, "kernel_launch: occupancy query says %d\n", per_cu); (void)hipGetLastError(); grid = -1; return; }
        grid = cus;
    }
    if (grid < 0) return;
    if (hipMemsetAsync((char*)d_ws + WS_CTL, 0, 16384, stream) != hipSuccess) { fprintf(stderr, "kernel_launch: memset failed\n"); return; }
    Args a{};
    for (int i = 0; i < 22; ++i) a.in[i] = (const float*)d_in[i];
    a.out = (float*)d_out; a.ws = (unsigned char*)d_ws;
#if MK_ONE_LAUNCH
    a.ph_lo = 0; a.ph_hi = PH_TOTAL;
    void* args[] = {&a};
    hipError_t e = hipLaunchCooperativeKernel((const void*)mega_fwd, dim3(grid), dim3(NTHREADS), args, LDS_BYTES, stream);
    if (e != hipSuccess) fprintf(stderr, "cooperative launch failed: %s (grid %d)\n", hipGetErrorString(e), grid);
#else
    for (int ph = 0; ph < PH_TOTAL; ++ph) { a.ph_lo = ph; a.ph_hi = ph + 1; hipLaunchKernelGGL(mega_fwd, dim3(grid), dim3(NTHREADS), LDS_BYTES, stream, a); }
#endif
}
```

```cpp
#include <hip/hip_runtime.h>
#include <hip/hip_cooperative_groups.h>
#include <cstdio>
#include <cstdint>
namespace cg = cooperative_groups;
namespace pg8 {
#define PG8_LAS __attribute__((address_space(3)))
typedef unsigned short bf16_t;
typedef short bf16x8 __attribute__((ext_vector_type(8)));
typedef float f32x4 __attribute__((ext_vector_type(4)));
typedef unsigned u32x4 __attribute__((ext_vector_type(4)));
constexpr int BM = 256, BK = 64, HALF = 128, HTB = HALF * BK * 2  , STAGE_BYTES = 8 * HTB, NXCD = 8, WGM = 8;

__host__ __device__ __forceinline__ int lds_byte(int r, int c) { const int st = (r >> 4) * 2 + (c >> 5), rr = r & 15, cc = c & 31, ob = rr * 64 + cc * 2; return st * 1024 + (ob ^ (((ob >> 9) & 1) << 5)); }
__host__ __device__ __forceinline__ void stage_rc(int b, int& R, int& C) { const int st = b / 1024, sb = b % 1024, swz = sb ^ (((sb >> 9) & 1) << 5); R = (st >> 1) * 16 + swz / 64; C = (st & 1) * 32 + (swz % 64) / 2; }
__host__ __device__ __forceinline__ int perm32(int rho) { const int n = rho >> 4, i = rho & 15; return 8 * (i >> 2) + 4 * n + (i & 3); }

struct Unit { int pm, pn; };
struct Gemm { const bf16_t* A; const bf16_t* Bt; int M, N, K, lda, ldb; };

struct StaticOrder {
    int nM, nN, nwg, G, c;
    __host__ __device__ void init(int M, int N, int G_, int c_) { nM = M / BM; nN = N / BM; nwg = nM * nN; G = G_; c = c_; }
    __host__ __device__ bool next(int i, Unit& u) const {
        const long L = (long)i * G + c; if (L >= nwg) return false;
        int wgid = (int)L; { const int q = nwg / NXCD, r = nwg % NXCD, xcd = wgid % NXCD, off = wgid / NXCD; wgid = (xcd < r ? xcd * (q + 1) : r * (q + 1) + (xcd - r) * q) + off; }
        const int nig = WGM * nN, gid = wgid / nig, fm = gid * WGM, gsz = (nM - fm) < WGM ? (nM - fm) : WGM;
        u.pm = fm + ((wgid % nig) % gsz); u.pn = (wgid % nig) / gsz; return true;
    }
    __device__ __forceinline__ void a_ready(const Unit&) const {}
    __device__ __forceinline__ void done(const Unit&) const {}
};

__device__ __forceinline__ unsigned cvt_pk_bf16(float lo, float hi) { unsigned r; asm volatile("v_cvt_pk_bf16_f32 %0, %1, %2" : "=v"(r) : "v"(lo), "v"(hi)); return r; }
__device__ __forceinline__ float bf_lo(unsigned w) { return __uint_as_float(w << 16); }
__device__ __forceinline__ float bf_hi(unsigned w) { return __uint_as_float(w & 0xffff0000u); }
__device__ __forceinline__ float sigmoidf_(float x) { return __builtin_amdgcn_rcpf(1.0f + __expf(-x)); }
typedef unsigned u32x2 __attribute__((ext_vector_type(2)));
__device__ __forceinline__ float row_rstd(const float* part, size_t row, int fq) {
    const f32x4 a = ((const f32x4*)(part + row * 16))[fq];
    float s = (a[0] + a[1]) + (a[2] + a[3]);
    s += __shfl_xor(s, 16); s += __shfl_xor(s, 32);
    return 1.0f / sqrtf(s * (1.0f / 1024.0f) + 1e-6f);
}
struct EpiSwiGLU {
    static constexpr bool PERM = true, AFTER_DRAIN = false;
    bf16_t* O; int ldc; const float* part;
    __device__ __forceinline__ void operator()(const f32x4 (&acc)[2][2][4][2], const Unit& u, int wr, int wc, int fr, int fq) const {
        const int col = u.pn * HALF + wc * 32 + 8 * fq;
#pragma unroll
        for (int ai = 0; ai < 2; ++ai)
#pragma unroll
            for (int m = 0; m < 4; ++m) { const size_t row = (size_t)(u.pm * BM + ai * HALF + wr * 64 + m * 16 + fr); float v[8];
#pragma unroll
                for (int n = 0; n < 2; ++n) { const f32x4 g = acc[ai][0][m][n], up = acc[ai][1][m][n];
#pragma unroll
                    for (int j = 0; j < 4; ++j) v[4 * n + j] = g[j] * sigmoidf_(g[j]) * up[j]; }
                u32x4 w; w.x = cvt_pk_bf16(v[0], v[1]); w.y = cvt_pk_bf16(v[2], v[3]); w.z = cvt_pk_bf16(v[4], v[5]); w.w = cvt_pk_bf16(v[6], v[7]);
                *(u32x4*)(O + row * ldc + col) = w; }
    }
};
struct EpiResid {
    static constexpr bool PERM = false, AFTER_DRAIN = false;
    const float* base; float* out; int ldc; float alpha;
    __device__ __forceinline__ void operator()(const f32x4 (&acc)[2][2][4][2], const Unit& u, int wr, int wc, int fr, int fq) const {
        const size_t off0 = (size_t)(u.pm * BM + wr * 64 + fr) * ldc + u.pn * BM + wc * 32 + 4 * fq;
        f32x4 cur[2][2], nxt[2][2];
#pragma unroll
        for (int bj = 0; bj < 2; ++bj)
#pragma unroll
            for (int n = 0; n < 2; ++n) cur[bj][n] = *(const f32x4*)(base + off0 + bj * HALF + n * 16);
#pragma unroll
        for (int gidx = 0; gidx < 8; ++gidx) { const int ai = gidx >> 2, m = gidx & 3; const size_t off = off0 + (size_t)(ai * HALF + m * 16) * ldc;
            if (gidx < 7) { const int ai2 = (gidx + 1) >> 2, m2 = (gidx + 1) & 3; const size_t offn = off0 + (size_t)(ai2 * HALF + m2 * 16) * ldc;
#pragma unroll
                for (int bj = 0; bj < 2; ++bj)
#pragma unroll
                    for (int n = 0; n < 2; ++n) nxt[bj][n] = *(const f32x4*)(base + offn + bj * HALF + n * 16); }
            asm volatile("" ::: "memory");
#pragma unroll
            for (int bj = 0; bj < 2; ++bj)
#pragma unroll
                for (int n = 0; n < 2; ++n) *(f32x4*)(out + off + bj * HALF + n * 16) = cur[bj][n] + acc[ai][bj][m][n] * alpha;
            asm volatile("" ::: "memory");
#pragma unroll
            for (int bj = 0; bj < 2; ++bj)
#pragma unroll
                for (int n = 0; n < 2; ++n) cur[bj][n] = nxt[bj][n]; }
    }
};
struct EpiBf16Mask {
    static constexpr bool PERM = true, AFTER_DRAIN = false;
    bf16_t* O; int ldc; int ncols; const float* part;
    __device__ __forceinline__ void operator()(const f32x4 (&acc)[2][2][4][2], const Unit& u, int wr, int wc, int fr, int fq) const {
        const int col0 = u.pn * BM + wc * 32 + 8 * fq;
        float rsv[2][4];
#pragma unroll
        for (int ai = 0; ai < 2; ++ai)
#pragma unroll
            for (int m = 0; m < 4; ++m) rsv[ai][m] = part ? row_rstd(part, (size_t)(u.pm * BM + ai * HALF + wr * 64 + m * 16 + fr), fq) : 1.0f;
#pragma unroll
        for (int ai = 0; ai < 2; ++ai)
#pragma unroll
            for (int m = 0; m < 4; ++m) { const size_t row = (size_t)(u.pm * BM + ai * HALF + wr * 64 + m * 16 + fr); bf16_t* rowp = O + row * ldc; const float rs = rsv[ai][m];
#pragma unroll
                for (int bj = 0; bj < 2; ++bj) { const f32x4 v0 = acc[ai][bj][m][0] * rs, v1 = acc[ai][bj][m][1] * rs;
                    u32x4 w; w.x = cvt_pk_bf16(v0[0], v0[1]); w.y = cvt_pk_bf16(v0[2], v0[3]); w.z = cvt_pk_bf16(v1[0], v1[1]); w.w = cvt_pk_bf16(v1[2], v1[3]);
                    const int c = col0 + bj * HALF; if (c < ncols) *(u32x4*)(rowp + c) = w; } }
    }
};
template <int MODE> struct EpiMerge {
    static constexpr bool PERM = true, AFTER_DRAIN = false;
    const bf16_t* gate; int ldg; bf16_t* H; int ldh;
    __device__ __forceinline__ void operator()(const f32x4 (&acc)[2][2][4][2], const Unit& u, int wr, int wc, int fr, int fq) const {
        const size_t row0 = (size_t)(u.pm * BM + wr * 64 + fr); const int c0 = u.pn * BM + wc * 32 + 8 * fq;
        u32x4 cg[2], ch[2], ng[2], nh[2];
#pragma unroll
        for (int bj = 0; bj < 2; ++bj) { cg[bj] = *(const u32x4*)(gate + row0 * ldg + c0 + bj * HALF); if (MODE == 1) ch[bj] = *(const u32x4*)(H + row0 * ldh + c0 + bj * HALF); }
#pragma unroll
        for (int gidx = 0; gidx < 8; ++gidx) { const int ai = gidx >> 2, m = gidx & 3; const size_t row = row0 + ai * HALF + m * 16;
            if (gidx < 7) { const size_t rn = row0 + ((gidx + 1) >> 2) * HALF + ((gidx + 1) & 3) * 16;
#pragma unroll
                for (int bj = 0; bj < 2; ++bj) { ng[bj] = *(const u32x4*)(gate + rn * ldg + c0 + bj * HALF); if (MODE == 1) nh[bj] = *(const u32x4*)(H + rn * ldh + c0 + bj * HALF); } }
            asm volatile("" ::: "memory");
#pragma unroll
            for (int bj = 0; bj < 2; ++bj) { const f32x4 a0 = acc[ai][bj][m][0], a1 = acc[ai][bj][m][1]; const u32x4 gw = cg[bj];
                float v0 = sigmoidf_(bf_lo(gw.x)) * a0[0], v1 = sigmoidf_(bf_hi(gw.x)) * a0[1], v2 = sigmoidf_(bf_lo(gw.y)) * a0[2], v3 = sigmoidf_(bf_hi(gw.y)) * a0[3];
                float v4 = sigmoidf_(bf_lo(gw.z)) * a1[0], v5 = sigmoidf_(bf_hi(gw.z)) * a1[1], v6 = sigmoidf_(bf_lo(gw.w)) * a1[2], v7 = sigmoidf_(bf_hi(gw.w)) * a1[3];
                if (MODE == 1) { const u32x4 hw = ch[bj]; v0 += bf_lo(hw.x); v1 += bf_hi(hw.x); v2 += bf_lo(hw.y); v3 += bf_hi(hw.y); v4 += bf_lo(hw.z); v5 += bf_hi(hw.z); v6 += bf_lo(hw.w); v7 += bf_hi(hw.w); }
                u32x4 w; w.x = cvt_pk_bf16(v0, v1); w.y = cvt_pk_bf16(v2, v3); w.z = cvt_pk_bf16(v4, v5); w.w = cvt_pk_bf16(v6, v7);
                *(u32x4*)(H + row * ldh + c0 + bj * HALF) = w; }
            asm volatile("" ::: "memory");
#pragma unroll
            for (int bj = 0; bj < 2; ++bj) { cg[bj] = ng[bj]; if (MODE == 1) ch[bj] = nh[bj]; } }
    }
};
struct EpiF32 {
    static constexpr bool PERM = false, AFTER_DRAIN = false;
    float* O; int ldc;
    __device__ __forceinline__ void operator()(const f32x4 (&acc)[2][2][4][2], const Unit& u, int wr, int wc, int fr, int fq) const {
#pragma unroll
        for (int ai = 0; ai < 2; ++ai)
#pragma unroll
            for (int m = 0; m < 4; ++m) { const size_t off = (size_t)(u.pm * BM + ai * HALF + wr * 64 + m * 16 + fr) * ldc + u.pn * BM + wc * 32 + 4 * fq;
#pragma unroll
                for (int bj = 0; bj < 2; ++bj)
#pragma unroll
                    for (int n = 0; n < 2; ++n) *(f32x4*)(O + off + bj * HALF + n * 16) = acc[ai][bj][m][n]; }
    }
};
struct EpiPle {
    static constexpr bool PERM = false, AFTER_DRAIN = false;
    const float* pp; float* out; int ldc; const float* part;
    __device__ __forceinline__ void operator()(const f32x4 (&acc)[2][2][4][2], const Unit& u, int wr, int wc, int fr, int fq) const {
        const size_t off0 = (size_t)(u.pm * BM + wr * 64 + fr) * ldc + u.pn * BM + wc * 32 + 4 * fq;
        f32x4 cp[2][2], cx[2][2], np[2][2], nx[2][2];
#pragma unroll
        for (int bj = 0; bj < 2; ++bj)
#pragma unroll
            for (int n = 0; n < 2; ++n) { cp[bj][n] = *(const f32x4*)(pp + off0 + bj * HALF + n * 16); cx[bj][n] = *(const f32x4*)(out + off0 + bj * HALF + n * 16); }
#pragma unroll
        for (int gidx = 0; gidx < 8; ++gidx) { const int ai = gidx >> 2, m = gidx & 3; const size_t off = off0 + (size_t)(ai * HALF + m * 16) * ldc;
            if (gidx < 7) { const int ai2 = (gidx + 1) >> 2, m2 = (gidx + 1) & 3; const size_t offn = off0 + (size_t)(ai2 * HALF + m2 * 16) * ldc;
#pragma unroll
                for (int bj = 0; bj < 2; ++bj)
#pragma unroll
                    for (int n = 0; n < 2; ++n) { np[bj][n] = *(const f32x4*)(pp + offn + bj * HALF + n * 16); nx[bj][n] = *(const f32x4*)(out + offn + bj * HALF + n * 16); } }
            asm volatile("" ::: "memory");
#pragma unroll
            for (int bj = 0; bj < 2; ++bj)
#pragma unroll
                for (int n = 0; n < 2; ++n) { const f32x4 a = acc[ai][bj][m][n]; const f32x4 p = cp[bj][n]; f32x4 x = cx[bj][n];
                    x[0] += sigmoidf_(a[0]) * p[0]; x[1] += sigmoidf_(a[1]) * p[1]; x[2] += sigmoidf_(a[2]) * p[2]; x[3] += sigmoidf_(a[3]) * p[3];
                    *(f32x4*)(out + off + bj * HALF + n * 16) = x; }
            asm volatile("" ::: "memory");
#pragma unroll
            for (int bj = 0; bj < 2; ++bj)
#pragma unroll
                for (int n = 0; n < 2; ++n) { cp[bj][n] = np[bj][n]; cx[bj][n] = nx[bj][n]; } }
    }
};

template <class Epi, class Sched, bool ALIGN_EPI = false, bool SP2 = false>
__device__ __forceinline__ void gemm_phase(PG8_LAS unsigned char* lds, const Gemm g, const Sched& S, const Epi& E, const int tid) {
    const int wid = __builtin_amdgcn_readfirstlane(tid >> 6), lane = tid & 63, wr = wid >> 2, wc = wid & 3, fr = lane & 15, fq = lane >> 4;
    int K = g.K; asm volatile("" : "+s"(K)); const int nt = K / BK;
    unsigned voffA[2], voffB[2];
#pragma unroll
    for (int i = 0; i < 2; ++i) { int R, C; stage_rc(tid * 16 + i * 8192, R, C); const int Rb = Epi::PERM ? ((R & ~31) + perm32(R & 31)) : R;
        voffA[i] = (unsigned)(R * g.lda + C) * 2u; voffB[i] = (unsigned)(Rb * g.ldb + C) * 2u; }
    const size_t kstep = (size_t)(BK * 2);
    const size_t hstepA = (size_t)HALF * g.lda * 2, hstepB = (size_t)HALF * g.ldb * 2;
    const size_t tstepA = 2 * hstepA, tstepB = 2 * hstepB;
    const unsigned ldsw = (unsigned)wid * 1024u;
    const int aoff = lds_byte(wr * 64 + fr, fq * 8), boff = lds_byte(wc * 32 + fr, fq * 8);
#define PG8_SA(b, h) (((b) * 2 + (h)) * HTB)
#define PG8_SB(b, h) ((4 + (b) * 2 + (h)) * HTB)
#define PG8_STAGE(bufoff, gbase, voff) do { _Pragma("unroll") for (int _i = 0; _i < 2; ++_i) \
        __builtin_amdgcn_global_load_lds((const unsigned*)((const char*)(gbase) + (voff)[_i]), (PG8_LAS unsigned*)(lds + (bufoff) + ldsw + _i * 8192), 16, 0, 0); } while (0)
#define PG8_LDA(dst, b, h) do { _Pragma("unroll") for (int m = 0; m < 4; ++m) _Pragma("unroll") for (int k = 0; k < 2; ++k) dst[m][k] = *(const PG8_LAS bf16x8*)(lds + PG8_SA(b, h) + aoff + m * 2048 + k * 1024); } while (0)
#define PG8_LDB(dst, b, h) do { _Pragma("unroll") for (int n = 0; n < 2; ++n) _Pragma("unroll") for (int k = 0; k < 2; ++k) dst[n][k] = *(const PG8_LAS bf16x8*)(lds + PG8_SB(b, h) + boff + n * 2048 + k * 1024); } while (0)
#define PG8_MMA(ai, bj, At, Bt) do { __builtin_amdgcn_s_setprio(1); _Pragma("unroll") for (int m = 0; m < 4; ++m) _Pragma("unroll") for (int n = 0; n < 2; ++n) _Pragma("unroll") for (int k = 0; k < 2; ++k) \
        acc[ai][bj][m][n] = __builtin_amdgcn_mfma_f32_16x16x32_bf16(Bt[n][k], At[m][k], acc[ai][bj][m][n], 0, 0, 0); __builtin_amdgcn_s_setprio(0); } while (0)
#define PG8_WAIT_V(n) asm volatile("s_waitcnt vmcnt(" #n ")" ::: "memory")
#define PG8_WAIT_L(n) asm volatile("s_waitcnt lgkmcnt(" #n ")" ::: "memory")
#define PG8_BAR __builtin_amdgcn_s_barrier()
#define PG8_SCHED __builtin_amdgcn_sched_barrier(0)
    Unit cur, nxt; int ui = 0;
    if (!S.next(0, cur)) return;
    f32x4 acc[2][2][4][2];
#pragma unroll
    for (int a = 0; a < 2; ++a)
#pragma unroll
        for (int b = 0; b < 2; ++b)
#pragma unroll
            for (int m = 0; m < 4; ++m)
#pragma unroll
                for (int n = 0; n < 2; ++n) acc[a][b][m][n] = (f32x4){0.f, 0.f, 0.f, 0.f};
    bf16x8 At[4][2], B0[2][2], B1[2][2];
    const char* cA = (const char*)g.A + (size_t)cur.pm * tstepA; const char* cB = (const char*)g.Bt + (size_t)cur.pn * tstepB;
    S.a_ready(cur);
    if constexpr (SP2) {
        PG8_STAGE(PG8_SB(0, 0), cB, voffB); PG8_STAGE(PG8_SB(0, 1), cB + hstepB, voffB); PG8_STAGE(PG8_SA(0, 0), cA, voffA); PG8_STAGE(PG8_SA(0, 1), cA + hstepA, voffA);
        if (wr == 1) PG8_BAR;
        PG8_WAIT_V(2); PG8_BAR;
        PG8_STAGE(PG8_SB(1, 0), cB + kstep, voffB); PG8_STAGE(PG8_SA(1, 0), cA + kstep, voffA); PG8_STAGE(PG8_SB(1, 1), cB + hstepB + kstep, voffB);
        PG8_WAIT_V(6); PG8_BAR;
    } else {
        PG8_STAGE(PG8_SB(0, 0), cB, voffB); PG8_STAGE(PG8_SA(0, 0), cA, voffA); PG8_STAGE(PG8_SB(0, 1), cB + hstepB, voffB); PG8_STAGE(PG8_SA(0, 1), cA + hstepA, voffA);
        if (wr == 1) PG8_BAR;
        PG8_WAIT_V(4); PG8_BAR;
        PG8_STAGE(PG8_SB(1, 0), cB + kstep, voffB); PG8_STAGE(PG8_SA(1, 0), cA + kstep, voffA); PG8_STAGE(PG8_SB(1, 1), cB + hstepB + kstep, voffB);
        PG8_WAIT_V(6); PG8_BAR;
    }
    for (;;) {
        const bool has_next = S.next(ui + 1, nxt);
        const char* nA = has_next ? (const char*)g.A + (size_t)nxt.pm * tstepA : cA; const char* nB = has_next ? (const char*)g.Bt + (size_t)nxt.pn * tstepB : cB;
        for (int t = 0; t < nt; t += 2) {
            const bool last = (t == nt - 2);
            const char* a1 = cA + (size_t)(t + 1) * kstep;
            const char* a2 = last ? nA : cA + (size_t)(t + 2) * kstep; const char* b2 = last ? nB : cB + (size_t)(t + 2) * kstep;
            const char* a3 = a2 + kstep; const char* b3 = b2 + kstep;
            if (last && has_next) S.a_ready(nxt);
            if constexpr (SP2) {
            PG8_LDB(B0, 0, 0); PG8_LDB(B1, 0, 1); PG8_SCHED; PG8_LDA(At, 0, 0); PG8_STAGE(PG8_SA(1, 1), a1 + hstepA, voffA);
            PG8_WAIT_V(8); PG8_WAIT_L(0); PG8_BAR; PG8_MMA(0, 0, At, B0); PG8_MMA(0, 1, At, B1); PG8_BAR; PG8_SCHED;
            PG8_LDA(At, 0, 1); PG8_STAGE(PG8_SB(0, 0), b2, voffB); PG8_STAGE(PG8_SB(0, 1), b2 + hstepB, voffB); PG8_STAGE(PG8_SA(0, 0), a2, voffA);
            PG8_WAIT_V(8); PG8_WAIT_L(0); PG8_BAR; PG8_MMA(1, 0, At, B0); PG8_MMA(1, 1, At, B1); PG8_BAR; PG8_SCHED;
            PG8_LDB(B0, 1, 0); PG8_LDB(B1, 1, 1); PG8_SCHED; PG8_LDA(At, 1, 0); PG8_STAGE(PG8_SA(0, 1), a2 + hstepA, voffA);
            PG8_WAIT_V(8); PG8_WAIT_L(0); PG8_BAR; PG8_MMA(0, 0, At, B0); PG8_MMA(0, 1, At, B1); PG8_BAR; PG8_SCHED;
            PG8_LDA(At, 1, 1); PG8_STAGE(PG8_SB(1, 0), b3, voffB); PG8_STAGE(PG8_SB(1, 1), b3 + hstepB, voffB); PG8_STAGE(PG8_SA(1, 0), a3, voffA);
            PG8_WAIT_V(8); PG8_WAIT_L(0); PG8_BAR; PG8_MMA(1, 0, At, B0); PG8_MMA(1, 1, At, B1); PG8_BAR; PG8_SCHED;
            } else {
            PG8_LDB(B0, 0, 0); PG8_SCHED; PG8_LDA(At, 0, 0); PG8_STAGE(PG8_SA(1, 1), a1 + hstepA, voffA);
            PG8_WAIT_L(8); PG8_BAR; PG8_WAIT_L(0); PG8_MMA(0, 0, At, B0); PG8_BAR; PG8_SCHED;
            PG8_LDB(B1, 0, 1); PG8_STAGE(PG8_SB(0, 0), b2, voffB);
            PG8_BAR; PG8_WAIT_L(0); PG8_MMA(0, 1, At, B1); PG8_BAR;
            PG8_LDA(At, 0, 1); PG8_STAGE(PG8_SA(0, 0), a2, voffA);
            PG8_BAR; PG8_WAIT_L(0); PG8_MMA(1, 0, At, B0); PG8_BAR; PG8_SCHED;
            PG8_STAGE(PG8_SB(0, 1), b2 + hstepB, voffB);
            PG8_WAIT_V(6); PG8_BAR; PG8_MMA(1, 1, At, B1); PG8_BAR;
            PG8_LDB(B0, 1, 0); PG8_SCHED; PG8_LDA(At, 1, 0); PG8_STAGE(PG8_SA(0, 1), a2 + hstepA, voffA);
            PG8_WAIT_L(8); PG8_BAR; PG8_WAIT_L(0); PG8_MMA(0, 0, At, B0); PG8_BAR; PG8_SCHED;
            PG8_LDB(B1, 1, 1); PG8_STAGE(PG8_SB(1, 0), b3, voffB);
            PG8_BAR; PG8_WAIT_L(0); PG8_MMA(0, 1, At, B1); PG8_BAR;
            PG8_LDA(At, 1, 1); PG8_STAGE(PG8_SA(1, 0), a3, voffA);
            PG8_BAR; PG8_WAIT_L(0); PG8_MMA(1, 0, At, B0); PG8_BAR; PG8_SCHED;
            PG8_STAGE(PG8_SB(1, 1), b3 + hstepB, voffB);
            PG8_WAIT_V(6); PG8_BAR; PG8_MMA(1, 1, At, B1); PG8_BAR;
            }
        }
        if constexpr (ALIGN_EPI) { if (wr == 0) PG8_BAR; }
        if constexpr (!Epi::AFTER_DRAIN) { E(acc, cur, wr, wc, fr, fq); S.done(cur); }
        if (!has_next) break;
#pragma unroll
        for (int a = 0; a < 2; ++a)
#pragma unroll
            for (int b = 0; b < 2; ++b)
#pragma unroll
                for (int m = 0; m < 4; ++m)
#pragma unroll
                    for (int n = 0; n < 2; ++n) acc[a][b][m][n] = (f32x4){0.f, 0.f, 0.f, 0.f};
        cur = nxt; cA = nA; cB = nB; ++ui;
        if constexpr (ALIGN_EPI) { if (wr == 1) PG8_BAR; }
    }
    PG8_WAIT_V(0);
    if constexpr (!ALIGN_EPI) { if (wr == 0) PG8_BAR; }
    PG8_BAR;
    if constexpr (Epi::AFTER_DRAIN) { E.fused(acc, cur, wr, wc, fr, fq, lds, wid, lane); S.done(cur); }
#undef PG8_SA
#undef PG8_SB
#undef PG8_STAGE
#undef PG8_LDA
#undef PG8_LDB
#undef PG8_MMA
#undef PG8_WAIT_V
#undef PG8_WAIT_L
#undef PG8_BAR
#undef PG8_SCHED
}
}
constexpr int NWAVES = 8, NTHREADS = 512;
constexpr int SEQ = 8192, NB = 2, T = NB * SEQ, D = 1024, FF = 2816, DEPTH = 2, PLE = 256;
constexpr int WIN = 5720, WINP = 5888, ZS = 5720;
constexpr int C_AQ = 0, C_AK = 512, C_AV = 1024, C_IQ = 1536, C_IK = 2048, C_IW = 2112, C_GQ = 2120, C_GK = 2376, C_GV = 2632, C_GR = 3144, C_GA = 3656, C_MGA = 3672, C_MGB = 4696;
constexpr float EPS = 1e-6f;
constexpr size_t MiB = 1u << 20;
constexpr size_t WB_GU1 = 0, WB_D1 = WB_GU1 + (size_t)2 * FF * D * 2, WB_IN = WB_D1 + (size_t)D * FF * 2, WB_A = WB_IN + (size_t)WINP * D * 2, WB_B = WB_A + (size_t)D * 512 * 2,
                 WB_O = WB_B + (size_t)D * 512 * 2, WB_GU2 = WB_O + (size_t)D * D * 2, WB_D2 = WB_GU2 + (size_t)2 * FF * D * 2, WB_PG = WB_D2 + (size_t)D * FF * 2, WB_PP = WB_PG + (size_t)D * D * 2,
                 WB_END = WB_PP + (size_t)D * PLE * 2;
static_assert(WB_END <= 52 * MiB, "weight copies");
constexpr size_t WS_H = 52 * MiB;
constexpr size_t WS_SMALL = 84 * MiB;
constexpr size_t WS_CTL = WS_SMALL + 512 * 1024, CTL_BYTES = 16384;
constexpr size_t WS_Z = 85 * MiB;
constexpr size_t WS_PB = WS_Z + 140 * MiB;
constexpr size_t WS_XB2 = WS_Z + 100 * MiB;
constexpr size_t WS_END = WS_Z + (size_t)T * ZS * 2;
constexpr size_t WS_MASK = 264 * MiB, WS_PART = WS_MASK + (size_t)T * 256 * 4, WS_ALL = WS_PART + (size_t)T * 16 * 4;
static_assert(WS_END <= WS_MASK, "ws map");
constexpr int RING_BYTES = 131072, LDSCTL_OFF = RING_BYTES, LDS_BYTES = 163840;

#define GAS __attribute__((address_space(1)))
#define LAS __attribute__((address_space(3)))
typedef unsigned short bf16;
typedef unsigned v4u __attribute__((ext_vector_type(4)));
typedef unsigned v2u __attribute__((ext_vector_type(2)));
typedef float f32x4 __attribute__((ext_vector_type(4)));
typedef float f32x16 __attribute__((ext_vector_type(16)));
typedef short bf16x8 __attribute__((ext_vector_type(8)));
#define LDS_FENCE() asm volatile("s_waitcnt lgkmcnt(0)" ::: "memory")
__device__ __forceinline__ unsigned f2bf(float f) { unsigned u = __builtin_bit_cast(unsigned, f); return (u + 0x7fffu + ((u >> 16) & 1u)) >> 16; }
__device__ __forceinline__ unsigned pk2(float lo, float hi) { return f2bf(lo) | (f2bf(hi) << 16); }
__device__ __forceinline__ float bflo(unsigned w) { return __uint_as_float(w << 16); }
__device__ __forceinline__ float bfhi(unsigned w) { return __uint_as_float(w & 0xffff0000u); }
__device__ __forceinline__ float wave_sum(float v) {
#pragma unroll
    for (int o = 1; o < 64; o <<= 1) v += __shfl_xor(v, o);
    return v;
}

struct Args { const float* in[22]; float* out; unsigned char* ws; int ph_lo, ph_hi; };
typedef const Args __attribute__((address_space(4))) * ArgsP;

__device__ __forceinline__ void transpose_item(const float* W, int K, int N, bf16* WT, int mode, LAS float* scr, int item, int lane, const float* gk = nullptr) {
    const int nblk = (N + 31) / 32, kb = item / nblk, nb = item % nblk, k0 = 64 * kb, n0 = 32 * nb;
    const int nn = n0 + (lane & 31); const bool okr = nn < N;
#pragma unroll 8
    for (int i = 0; i < 32; ++i) { const int kk = 2 * i + (lane >> 5); float w = okr ? W[(size_t)(k0 + kk) * N + nn] : 0.f; if (gk) w *= gk[k0 + kk]; scr[kk * 33 + (lane & 31)] = w; }
    LDS_FENCE();
    const int c = lane & 7;
#pragma unroll
    for (int j = 0; j < 4; ++j) { const int nl = (lane >> 3) + 8 * j; const int n = n0 + nl; const LAS float* s = scr + (8 * c) * 33 + nl;
        v4u o; o.x = pk2(s[0 * 33], s[1 * 33]); o.y = pk2(s[2 * 33], s[3 * 33]); o.z = pk2(s[4 * 33], s[5 * 33]); o.w = pk2(s[6 * 33], s[7 * 33]);
        const int row = mode == 0 ? n : (256 * (n >> 7) + (n & 127) + (mode == 2 ? 128 : 0));
        if (n < N) *(v4u*)(WT + (size_t)row * K + k0 + 8 * c) = o; }
    LDS_FENCE();
}
struct CvtDesc { const float* W; bf16* WT; int K, N, mode, item; };
__device__ __forceinline__ CvtDesc cvt_decode(ArgsP a, int L, int it) {
    constexpr int I_GU = (D / 64) * (FF / 32), I_DN = (FF / 64) * (D / 32), I_IN = (D / 64) * ((WIN + 31) / 32), I_BR = (512 / 64) * (D / 32), I_SQ = (D / 64) * (D / 32);
    int r = it;
    if (r < I_GU) return CvtDesc{a->in[13] + (size_t)L * D * FF, (bf16*)(a->ws + WB_GU1), D, FF, 1, r}; r -= I_GU;
    if (r < I_GU) return CvtDesc{a->in[14] + (size_t)L * D * FF, (bf16*)(a->ws + WB_GU1), D, FF, 2, r}; r -= I_GU;
    if (r < I_DN) return CvtDesc{a->in[15] + (size_t)L * D * FF, (bf16*)(a->ws + WB_D1), FF, D, 0, r}; r -= I_DN;
    if (r < I_IN) return CvtDesc{a->in[2] + (size_t)L * D * WIN, (bf16*)(a->ws + WB_IN), D, WIN, 0, r}; r -= I_IN;
    if (r < I_BR) return CvtDesc{a->in[6] + (size_t)L * 512 * D, (bf16*)(a->ws + WB_A), 512, D, 0, r}; r -= I_BR;
    if (r < I_BR) return CvtDesc{a->in[7] + (size_t)L * 512 * D, (bf16*)(a->ws + WB_B), 512, D, 0, r}; r -= I_BR;
    if (r < I_SQ) return CvtDesc{a->in[8] + (size_t)L * D * D, (bf16*)(a->ws + WB_O), D, D, 0, r}; r -= I_SQ;
    if (r < I_GU) return CvtDesc{a->in[16] + (size_t)L * D * FF, (bf16*)(a->ws + WB_GU2), D, FF, 1, r}; r -= I_GU;
    if (r < I_GU) return CvtDesc{a->in[17] + (size_t)L * D * FF, (bf16*)(a->ws + WB_GU2), D, FF, 2, r}; r -= I_GU;
    if (r < I_DN) return CvtDesc{a->in[18] + (size_t)L * D * FF, (bf16*)(a->ws + WB_D2), FF, D, 0, r}; r -= I_DN;
    if (r < I_SQ) return CvtDesc{a->in[20] + (size_t)L * D * D, (bf16*)(a->ws + WB_PG), D, D, 0, r}; r -= I_SQ;
    return CvtDesc{a->in[19] + (size_t)L * PLE * D, (bf16*)(a->ws + WB_PP), PLE, D, 0, r};
}
__device__ __forceinline__ void cvt_load(const CvtDesc& d, int lane, float (&pre)[32]) {
    const int nblk = (d.N + 31) / 32, kb = d.item / nblk, nb = d.item % nblk, k0 = 64 * kb, n0 = 32 * nb;
    const int nn = n0 + (lane & 31); const bool okr = nn < d.N; const float* p = d.W + (size_t)(k0 + (lane >> 5)) * d.N + (okr ? nn : 0);
#pragma unroll
    for (int i = 0; i < 32; ++i) { const float w = p[(size_t)(2 * i) * d.N]; pre[i] = okr ? w : 0.f; }
}
__device__ __forceinline__ void convert_weights(ArgsP a, int L, LAS unsigned char* lds, int wave, int lane, const int TID, const int BID) {
    LAS float* scr = (LAS float*)(lds + wave * 16384);
    const int gw = BID * NWAVES + wave, NGW = gridDim.x * NWAVES;
    constexpr int I_GU = (D / 64) * (FF / 32), I_DN = (FF / 64) * (D / 32), I_IN = (D / 64) * ((WIN + 31) / 32), I_BR = (512 / 64) * (D / 32), I_SQ = (D / 64) * (D / 32), I_PP = (PLE / 64) * (D / 32);
    constexpr int NITEMS = 4 * I_GU + 2 * I_DN + I_IN + 2 * I_BR + 2 * I_SQ + I_PP;
    int it = gw;
    if (it < NITEMS) {
        float pre[32];
        CvtDesc cur = cvt_decode(a, L, it); cvt_load(cur, lane, pre);
        for (;;) {
#pragma unroll
            for (int i = 0; i < 32; ++i) scr[(2 * i + (lane >> 5)) * 33 + (lane & 31)] = pre[i];
            const int nit = it + NGW; const bool hn = nit < NITEMS;
            const CvtDesc nxt = cvt_decode(a, L, hn ? nit : it);
            if (hn) cvt_load(nxt, lane, pre);
            LDS_FENCE();
            { const int nblk = (cur.N + 31) / 32, kb = cur.item / nblk, nb = cur.item % nblk, k0 = 64 * kb, n0 = 32 * nb; const int c = lane & 7;
#pragma unroll
              for (int j = 0; j < 4; ++j) { const int nl = (lane >> 3) + 8 * j; const int n = n0 + nl; const LAS float* sp = scr + (8 * c) * 33 + nl;
                  v4u o; o.x = pk2(sp[0 * 33], sp[1 * 33]); o.y = pk2(sp[2 * 33], sp[3 * 33]); o.z = pk2(sp[4 * 33], sp[5 * 33]); o.w = pk2(sp[6 * 33], sp[7 * 33]);
                  const int row = cur.mode == 0 ? n : (256 * (n >> 7) + (n & 127) + (cur.mode == 2 ? 128 : 0));
                  if (n < cur.N) *(v4u*)(cur.WT + (size_t)row * cur.K + k0 + 8 * c) = o; } }
            LDS_FENCE();
            if (!hn) break;
            cur = nxt; it = nit;
        }
    }
    { v4u* p = (v4u*)(a->ws + WB_IN + (size_t)WIN * D * 2); const int n16 = (WINP - WIN) * D * 2 / 16;
      for (int i = BID * NTHREADS + TID; i < n16; i += gridDim.x * NTHREADS) p[i] = (v4u){0u, 0u, 0u, 0u}; }
}
__device__ __forceinline__ void norm_rows(const float* x, const float* g, bf16* H, int wave, int lane, const int TID, const int BID) {
    const int gw = BID * NWAVES + wave, NGW = gridDim.x * NWAVES;
    f32x4 gv[4];
#pragma unroll
    for (int j = 0; j < 4; ++j) gv[j] = ((const f32x4*)g)[lane + 64 * j];
    for (int m = gw; m < T; m += 8 * NGW) {
        f32x4 v[8][4]; float ss[8]; int rowi[8];
#pragma unroll
        for (int r = 0; r < 8; ++r) { const int mr = m + r * NGW; rowi[r] = mr < T ? mr : m; const f32x4* xr = (const f32x4*)(x + (size_t)rowi[r] * D) + lane;
#pragma unroll
            for (int j = 0; j < 4; ++j) v[r][j] = xr[64 * j]; }
#pragma unroll
        for (int r = 0; r < 8; ++r) { float s = 0.f;
#pragma unroll
            for (int j = 0; j < 4; ++j) s += (v[r][j].x * v[r][j].x + v[r][j].y * v[r][j].y) + (v[r][j].z * v[r][j].z + v[r][j].w * v[r][j].w);
            ss[r] = s; }
#pragma unroll
        for (int o = 1; o < 64; o <<= 1) {
#pragma unroll
            for (int r = 0; r < 8; ++r) ss[r] += __shfl_xor(ss[r], o); }
#pragma unroll
        for (int r = 0; r < 8; ++r) { if (r == 0 || m + r * NGW < T) { const float rstd = 1.0f / sqrtf(ss[r] * (1.f / D) + EPS); v2u* o8 = (v2u*)(H + (size_t)rowi[r] * D) + lane;
#pragma unroll
            for (int j = 0; j < 4; ++j) { v2u w; w.x = pk2(v[r][j].x * rstd * gv[j].x, v[r][j].y * rstd * gv[j].y); w.y = pk2(v[r][j].z * rstd * gv[j].z, v[r][j].w * rstd * gv[j].w); o8[64 * j] = w; } } }
    }
}
__device__ __forceinline__ void norm_rows_f32(float* x, const float* g, int wave, int lane, const int TID, const int BID) {
    const int gw = BID * NWAVES + wave, NGW = gridDim.x * NWAVES;
    f32x4 gv[4];
#pragma unroll
    for (int j = 0; j < 4; ++j) gv[j] = ((const f32x4*)g)[lane + 64 * j];
    for (int m = gw; m < T; m += 8 * NGW) {
        f32x4 v[8][4]; float ss[8]; int rowi[8];
#pragma unroll
        for (int r = 0; r < 8; ++r) { const int mr = m + r * NGW; rowi[r] = mr < T ? mr : m; const f32x4* xr = (const f32x4*)(x + (size_t)rowi[r] * D) + lane;
#pragma unroll
            for (int j = 0; j < 4; ++j) v[r][j] = xr[64 * j]; }
#pragma unroll
        for (int r = 0; r < 8; ++r) { float s = 0.f;
#pragma unroll
            for (int j = 0; j < 4; ++j) s += (v[r][j].x * v[r][j].x + v[r][j].y * v[r][j].y) + (v[r][j].z * v[r][j].z + v[r][j].w * v[r][j].w);
            ss[r] = s; }
#pragma unroll
        for (int o = 1; o < 64; o <<= 1) {
#pragma unroll
            for (int r = 0; r < 8; ++r) ss[r] += __shfl_xor(ss[r], o); }
#pragma unroll
        for (int r = 0; r < 8; ++r) { if (r == 0 || m + r * NGW < T) { const float rstd = 1.0f / sqrtf(ss[r] * (1.f / D) + EPS); f32x4* xr = (f32x4*)(x + (size_t)rowi[r] * D) + lane;
#pragma unroll
            for (int j = 0; j < 4; ++j) xr[64 * j] = v[r][j] * rstd * gv[j]; } }
    }
}
__device__ __forceinline__ void convert_p(const float* p, bf16* pb, const int TID, const int BID) {
    const int n4 = T * PLE / 4, stride = gridDim.x * NTHREADS;
    for (int i = BID * NTHREADS + TID; i < n4; i += 8 * stride) {
        f32x4 v[8];
#pragma unroll
        for (int r = 0; r < 8; ++r) { const int ir = i + r * stride; v[r] = ((const f32x4*)p)[ir < n4 ? ir : i]; }
#pragma unroll
        for (int r = 0; r < 8; ++r) { const int ir = i + r * stride; if (ir < n4) { v2u w; w.x = pk2(v[r].x, v[r].y); w.y = pk2(v[r].z, v[r].w); ((v2u*)pb)[ir] = w; } }
    }
}
#define RLX_AGENT __ATOMIC_RELAXED, __HIP_MEMORY_SCOPE_AGENT
#define XB_TMO      128
#define XB_XCNT(j)  (256  + 64 * (j))
#define XB_XSUB(j)  (1280 + 64 * (j))
#define XB_XGEN(j)  (2304 + 64 * (j))
#define XB_TOP      3328
#define XB_TOPGEN   3392
#define XCD_BAR_WORDS 3456
#define XB_SPIN_CAP (1u << 18)

__device__ __forceinline__ unsigned xb_ld(unsigned* p)              { return __hip_atomic_load(p, __ATOMIC_RELAXED, __HIP_MEMORY_SCOPE_AGENT); }
__device__ __forceinline__ unsigned xb_add(unsigned* p, unsigned v) { return __hip_atomic_fetch_add(p, v, __ATOMIC_RELAXED, __HIP_MEMORY_SCOPE_AGENT); }
__device__ __forceinline__ unsigned xb_xcc_id() { return (unsigned)__builtin_amdgcn_s_getreg((3 << 11) | 20) & 0xFu; }
#define XB_SPIN(cond, bar) do { unsigned _sp = 0; while (cond) { __builtin_amdgcn_s_sleep(1); \
    if ((++_sp & 255u) == 0u) { if (xb_ld(&(bar)[XB_TMO])) break; if (_sp > XB_SPIN_CAP) { atomicAdd(&(bar)[XB_TMO], 1u); break; } } } } while (0)

struct XcdBarrier {
    unsigned* bar; unsigned x;
    volatile LAS unsigned* st;
};

__device__ __forceinline__ XcdBarrier xcd_barrier_post(unsigned* bar, volatile LAS unsigned* st) {
    XcdBarrier b; b.bar = bar; b.x = xb_xcc_id(); b.st = st;
    if (threadIdx.x == 0) (void)xb_add(&bar[XB_XCNT(b.x)], 1u);
    return b;
}
__device__ __forceinline__ void xcd_barrier_complete(unsigned* bar, unsigned x, unsigned& nloc, unsigned& nx) {
    const unsigned G = gridDim.x * gridDim.y * gridDim.z;
    unsigned sum, cnt, mine, sp = 0u;
    for (;;) {
        sum = 0u; cnt = 0u; mine = 0u;
#pragma unroll
        for (unsigned j = 0; j < 16; ++j) { const unsigned c = xb_ld(&bar[XB_XCNT(j)]); sum += c; cnt += (c > 0u) ? 1u : 0u; mine = (j == x) ? c : mine; }
        if (sum == G) break;
        __builtin_amdgcn_s_sleep(1);
        if ((++sp & 255u) == 0u) { if (xb_ld(&bar[XB_TMO])) break; if (sp > XB_SPIN_CAP) { atomicAdd(&bar[XB_TMO], 1u); break; } }
    }
    nloc = mine > 0u ? mine : 1u; nx = cnt > 0u ? cnt : 1u;
}

__device__ __forceinline__ void xcd_barrier(const XcdBarrier& b) {
    asm volatile("s_waitcnt vmcnt(0)" ::: "memory");
    __syncthreads();
    if (threadIdx.x == 0) {
        unsigned* bar = b.bar;
        __builtin_amdgcn_s_waitcnt(0);
        unsigned nloc = b.st[0], nx = b.st[1];
        if (nloc == 0u) { xcd_barrier_complete(bar, b.x, nloc, nx); b.st[0] = nloc; b.st[1] = nx; }
        const unsigned old = xb_add(&bar[XB_XSUB(b.x)], 1u);
        const unsigned gen = old / nloc;
        if (old + 1u == (gen + 1u) * nloc) {
            __builtin_amdgcn_fence(__ATOMIC_RELEASE, "agent");
            asm volatile("s_waitcnt vmcnt(0)" ::: "memory");
            const unsigned og = xb_add(&bar[XB_TOP], 1u);
            const unsigned tg = og / nx;
            if (og + 1u == (tg + 1u) * nx) xb_add(&bar[XB_TOPGEN], 1u);
            else XB_SPIN(xb_ld(&bar[XB_TOPGEN]) == tg, bar);
            __builtin_amdgcn_fence(__ATOMIC_ACQUIRE, "agent");
            xb_add(&bar[XB_XGEN(b.x)], 1u);
            asm volatile("s_waitcnt vmcnt(0)" ::: "memory");
        } else {
            XB_SPIN(xb_ld(&bar[XB_XGEN(b.x)]) == gen, bar);
            __builtin_amdgcn_fence(__ATOMIC_ACQUIRE, "agent");
            asm volatile("s_waitcnt vmcnt(0)" ::: "memory");
        }
    }
    __syncthreads();
}
constexpr int GL_BS = 0, GL_SEG = 16640, GL_X0 = 18688, GL_X1 = GL_X0 + 9216, GL_X2 = GL_X1 + 9216, GL_Y0 = GL_X2 + 9216, GL_VS = GL_Y0 + 18432, GL_OS = GL_VS + 20480, GL_END = GL_OS + 64 * 132 * 4;
constexpr int GL_KS = GL_X0;
constexpr int VSP = 320, KSP = 192;
static_assert(GL_END <= RING_BYTES && GL_KS + 64 * KSP <= GL_Y0, "GLA LDS");
typedef short gv4i16 __attribute__((ext_vector_type(4)));
__device__ __forceinline__ bf16x8 tr_frag(LAS unsigned char* img, int pitch, int k0, int n0, int lane) {
    const int tq = (lane >> 2) & 3, tp = lane & 3;
    LAS unsigned char* a = img + (k0 + tq) * pitch + (n0 + 4 * tp) * 2;
    const gv4i16 lo = __builtin_amdgcn_ds_read_tr16_b64_v4i16((LAS gv4i16*)a), hi = __builtin_amdgcn_ds_read_tr16_b64_v4i16((LAS gv4i16*)(a + 4 * pitch));
    return (bf16x8){lo[0], lo[1], lo[2], lo[3], hi[0], hi[1], hi[2], hi[3]};
}
constexpr int LP = 72;
__device__ __forceinline__ void gla_cumdecay(const bf16* z, size_t row0, int h, const float* w2, const float* bias, LAS unsigned char* lds, const int TID) {
    LAS float* bS = (LAS float*)(lds + GL_BS); LAS float* seg = (LAS float*)(lds + GL_SEG);
    const int tid = TID, d = tid & 63, sg = tid >> 6;
    float w[16];
#pragma unroll
    for (int r = 0; r < 16; ++r) w[r] = w2[r * 256 + h * 64 + d];
    const float bb = bias[h * 64 + d];
    float run = 0.f;
#pragma unroll
    for (int i = 0; i < 8; ++i) { const int s = 8 * sg + i; const v4u* gp = (const v4u*)(z + (row0 + s) * ZS + C_GA); const v4u g0 = gp[0], g1 = gp[1];
        float a = bb;
        a += bflo(g0.x) * w[0] + bfhi(g0.x) * w[1] + bflo(g0.y) * w[2] + bfhi(g0.y) * w[3] + bflo(g0.z) * w[4] + bfhi(g0.z) * w[5] + bflo(g0.w) * w[6] + bfhi(g0.w) * w[7];
        a += bflo(g1.x) * w[8] + bfhi(g1.x) * w[9] + bflo(g1.y) * w[10] + bfhi(g1.y) * w[11] + bflo(g1.z) * w[12] + bfhi(g1.z) * w[13] + bflo(g1.w) * w[14] + bfhi(g1.w) * w[15];
        const float ls = fminf(a, 0.f) - __logf(1.0f + __expf(-fabsf(a)));
        run += ls * (1.0f / 16.0f); bS[s * 65 + d] = run; }
    seg[sg * 64 + d] = run;
    __syncthreads();
    float off = 0.f;
#pragma unroll
    for (int j = 0; j < 8; ++j) if (j < sg) off += seg[j * 64 + d];
#pragma unroll
    for (int i = 0; i < 8; ++i) { const int s = 8 * sg + i; bS[s * 65 + d] += off; }
    __syncthreads();
}
__device__ __forceinline__ void gla_stage_v(const bf16* z, size_t row0, int h, LAS unsigned char* vS, const int TID) {
    const int tid = TID, s = tid >> 3, eg = tid & 7;
    const v4u* vp = (const v4u*)(z + (row0 + s) * ZS + C_GV + h * 128 + 16 * eg); const v4u a = vp[0], b = vp[1];
    *(LAS v4u*)(vS + s * VSP + eg * 32) = a; *(LAS v4u*)(vS + s * VSP + eg * 32 + 16) = b;
}
__device__ __forceinline__ void gla_local_item(const bf16* z, int item, const float* w2, const float* bias, float* dS, float* Adec, LAS unsigned char* lds, const int TID) {
    const int c = item & 127, h = (item >> 7) & 3, b = item >> 9; const size_t row0 = (size_t)b * SEQ + c * 64;
    gla_cumdecay(z, row0, h, w2, bias, lds, TID);
    LAS float* bS = (LAS float*)(lds + GL_BS); LAS unsigned char* ksS = lds + GL_KS; LAS unsigned char* vS = lds + GL_VS;
    const int tid = TID, lane = tid & 63, wave = tid >> 6;
    { const int s = tid >> 3, dg = tid & 7; const v4u kw = *(const v4u*)(z + (row0 + s) * ZS + C_GK + h * 64 + 8 * dg);
      const unsigned w[4] = {kw.x, kw.y, kw.z, kw.w}; unsigned o[4];
#pragma unroll
      for (int j = 0; j < 4; ++j) { const int d0 = 8 * dg + 2 * j;
          o[j] = pk2(bflo(w[j]) * __expf(bS[63 * 65 + d0] - bS[s * 65 + d0]), bfhi(w[j]) * __expf(bS[63 * 65 + d0 + 1] - bS[s * 65 + d0 + 1])); }
      *(LAS v4u*)(ksS + s * KSP + dg * 16) = (v4u){o[0], o[1], o[2], o[3]}; }
    gla_stage_v(z, row0, h, vS, TID);
    if (tid < 64) Adec[(size_t)item * 64 + tid] = expf(bS[63 * 65 + tid]);
    __syncthreads();
    { const int te = wave >> 1, td = wave & 1, l32 = lane & 31, hl = lane >> 5, tg = (lane >> 4) & 1; f32x16 acc = {};
#pragma unroll
      for (int ks = 0; ks < 4; ++ks) { const bf16x8 av = tr_frag(vS, VSP, 16 * ks + 8 * hl, 32 * te + 16 * tg, lane); const bf16x8 bv = tr_frag(ksS, KSP, 16 * ks + 8 * hl, 32 * td + 16 * tg, lane);
          acc = __builtin_amdgcn_mfma_f32_32x32x16_bf16(av, bv, acc, 0, 0, 0); }
      float* o = dS + (size_t)item * 8192;
#pragma unroll
      for (int r = 0; r < 16; ++r) { const int e = 32 * te + 8 * (r >> 2) + 4 * hl + (r & 3), d = 32 * td + l32; o[e * 64 + d] = acc[r]; } }
    __syncthreads();
}
__device__ __forceinline__ void gla_scan(float* dS, const float* Adec, const int TID, const int BID) {
    if (TID >= 256) return;
    const int gid = BID * 256 + TID;
    if (gid >= 8 * 8192) return;
    const int bh = gid >> 13, i = gid & 8191, d = i & 63;
    float st = 0.f; float* p = dS + (size_t)bh * 128 * 8192 + i; const float* ap = Adec + (size_t)bh * 128 * 64 + d;
    for (int c0 = 0; c0 < 128; c0 += 64) {
        float tv[64], av[64];
#pragma unroll
        for (int j = 0; j < 64; ++j) { tv[j] = p[(size_t)(c0 + j) * 8192]; av[j] = ap[(c0 + j) * 64]; }
#pragma unroll
        for (int j = 0; j < 64; ++j) { p[(size_t)(c0 + j) * 8192] = st; st = av[j] * st + tv[j]; }
    }
}
__device__ __forceinline__ void gla_out_item(bf16* z, int item, const float* w2, const float* bias, const float* gnorm, const float* Sin, LAS unsigned char* lds, const int TID) {
    const int c = item & 127, h = (item >> 7) & 3, b = item >> 9; const size_t row0 = (size_t)b * SEQ + c * 64;
    gla_cumdecay(z, row0, h, w2, bias, lds, TID);
    LAS float* bS = (LAS float*)(lds + GL_BS); LAS bf16* qe = (LAS bf16*)(lds + GL_X0); LAS bf16* ke = (LAS bf16*)(lds + GL_X1); LAS bf16* at = (LAS bf16*)(lds + GL_X2);
    LAS bf16* STb = (LAS bf16*)(lds + GL_Y0); LAS unsigned char* vS = lds + GL_VS; LAS float* oS = (LAS float*)(lds + GL_OS);
    const int tid = TID, lane = tid & 63, wave = tid >> 6, l32 = lane & 31, hl = lane >> 5;
    { const int s = tid >> 3, dg = tid & 7; const v4u qw = *(const v4u*)(z + (row0 + s) * ZS + C_GQ + h * 64 + 8 * dg); const v4u kw = *(const v4u*)(z + (row0 + s) * ZS + C_GK + h * 64 + 8 * dg);
      const unsigned wq[4] = {qw.x, qw.y, qw.z, qw.w}, wk[4] = {kw.x, kw.y, kw.z, kw.w}; unsigned oq[4], ok[4];
#pragma unroll
      for (int j = 0; j < 4; ++j) { const int d0 = 8 * dg + 2 * j; const float b0 = bS[s * 65 + d0], b1 = bS[s * 65 + d0 + 1]; const float e0 = __expf(b0), e1 = __expf(b1);
          oq[j] = pk2(bflo(wq[j]) * 0.125f * e0, bfhi(wq[j]) * 0.125f * e1); ok[j] = pk2(bflo(wk[j]) / e0, bfhi(wk[j]) / e1); }
      *(LAS v4u*)(qe + s * LP + 8 * dg) = (v4u){oq[0], oq[1], oq[2], oq[3]}; *(LAS v4u*)(ke + s * LP + 8 * dg) = (v4u){ok[0], ok[1], ok[2], ok[3]}; }
    { const int e = tid >> 2, dq = tid & 3; const f32x4* sp = (const f32x4*)(Sin + (size_t)item * 8192 + e * 64 + 16 * dq); const f32x4 s0 = sp[0], s1 = sp[1], s2 = sp[2], s3 = sp[3];
      *(LAS v4u*)(STb + e * LP + 16 * dq) = (v4u){pk2(s0.x, s0.y), pk2(s0.z, s0.w), pk2(s1.x, s1.y), pk2(s1.z, s1.w)};
      *(LAS v4u*)(STb + e * LP + 16 * dq + 8) = (v4u){pk2(s2.x, s2.y), pk2(s2.z, s2.w), pk2(s3.x, s3.y), pk2(s3.z, s3.w)}; }
    gla_stage_v(z, row0, h, vS, TID);
    __syncthreads();
    if (wave < 4) { const int tt = wave >> 1, ts = wave & 1; f32x16 acc = {};
#pragma unroll
      for (int ks = 0; ks < 4; ++ks) { const bf16x8 av = *(const LAS bf16x8*)(qe + (32 * tt + l32) * LP + 16 * ks + 8 * hl); const bf16x8 bv = *(const LAS bf16x8*)(ke + (32 * ts + l32) * LP + 16 * ks + 8 * hl);
          acc = __builtin_amdgcn_mfma_f32_32x32x16_bf16(av, bv, acc, 0, 0, 0); }
#pragma unroll
      for (int r = 0; r < 16; ++r) { const int t = 32 * tt + 8 * (r >> 2) + 4 * hl + (r & 3), s = 32 * ts + l32; at[t * LP + s] = (bf16)f2bf(s <= t ? acc[r] : 0.f); } }
    __syncthreads();
    { const int tt = wave >> 2, te = wave & 3; f32x16 acc = {};
#pragma unroll
      for (int ks = 0; ks < 4; ++ks) { const bf16x8 av = *(const LAS bf16x8*)(qe + (32 * tt + l32) * LP + 16 * ks + 8 * hl); const bf16x8 bv = *(const LAS bf16x8*)(STb + (32 * te + l32) * LP + 16 * ks + 8 * hl);
          acc = __builtin_amdgcn_mfma_f32_32x32x16_bf16(av, bv, acc, 0, 0, 0); }
#pragma unroll
      for (int ks = 0; ks < 4; ++ks) { const bf16x8 av = *(const LAS bf16x8*)(at + (32 * tt + l32) * LP + 16 * ks + 8 * hl); const bf16x8 bv = tr_frag(vS, VSP, 16 * ks + 8 * hl, 32 * te + 16 * ((lane >> 4) & 1), lane);
          acc = __builtin_amdgcn_mfma_f32_32x32x16_bf16(av, bv, acc, 0, 0, 0); }
#pragma unroll
      for (int r = 0; r < 16; ++r) { const int t = 32 * tt + 8 * (r >> 2) + 4 * hl + (r & 3), e = 32 * te + l32; oS[t * 132 + e] = acc[r]; } }
    __syncthreads();
    { const int t = tid >> 3, eg = tid & 7; float o[16]; float ss = 0.f;
#pragma unroll
      for (int j = 0; j < 4; ++j) { const f32x4 v = *(const LAS f32x4*)(oS + t * 132 + 16 * eg + 4 * j); o[4 * j] = v.x; o[4 * j + 1] = v.y; o[4 * j + 2] = v.z; o[4 * j + 3] = v.w; ss += (v.x * v.x + v.y * v.y) + (v.z * v.z + v.w * v.w); }
      ss += __shfl_xor(ss, 1); ss += __shfl_xor(ss, 2); ss += __shfl_xor(ss, 4);
      const float rstd = 1.0f / sqrtf(ss * (1.0f / 128.0f) + EPS);
      const v4u* gp = (const v4u*)(z + (row0 + t) * ZS + C_GR + h * 128 + 16 * eg); const v4u g0 = gp[0], g1 = gp[1]; const unsigned gw[8] = {g0.x, g0.y, g0.z, g0.w, g1.x, g1.y, g1.z, g1.w};
      unsigned ow[8];
#pragma unroll
      for (int j = 0; j < 8; ++j) { const float ga = bflo(gw[j]), gb = bfhi(gw[j]); const float sa = ga / (1.0f + __expf(-ga)), sb = gb / (1.0f + __expf(-gb));
          ow[j] = pk2(o[2 * j] * rstd * gnorm[16 * eg + 2 * j] * sa, o[2 * j + 1] * rstd * gnorm[16 * eg + 2 * j + 1] * sb); }
      v4u* op = (v4u*)(z + (row0 + t) * ZS + C_GV + h * 128 + 16 * eg); op[0] = (v4u){ow[0], ow[1], ow[2], ow[3]}; op[1] = (v4u){ow[4], ow[5], ow[6], ow[7]}; }
    __syncthreads();
}
constexpr int DS_SEL = 0, DS_CI = 2048, DS_CV = 2048, DS_LG = 10240;
constexpr int NBIN = 1024, TOPK = 256;
constexpr int KST_OFF = LDSCTL_OFF + 2048;
#define GLD16(dst, ptr) asm volatile("global_load_dwordx4 %0, %1, off" : "=&v"(dst) : "v"(ptr) : "memory")
#define GLD8(dst, ptr) asm volatile("global_load_dwordx2 %0, %1, off" : "=&v"(dst) : "v"(ptr) : "memory")
#define VM_WAIT(n, reg) asm volatile("s_waitcnt vmcnt(" #n ")" : "+v"(reg) : : "memory")
#define LDS_BAR() do { asm volatile("s_waitcnt lgkmcnt(0)" ::: "memory"); __builtin_amdgcn_s_barrier(); asm volatile("" ::: "memory"); } while (0)
__device__ __forceinline__ unsigned kswz(int key, int c) { return (unsigned)(key * 128 + ((c ^ ((key >> 1) & 7)) << 4)); }
__device__ __forceinline__ unsigned vrow(int key, int c) { return (unsigned)(key * 128 + ((c ^ (((key >> 1) & 1) << 2)) << 4)); }
typedef short v4i16_t __attribute__((ext_vector_type(4)));
__device__ __forceinline__ int score_bin(float v) {
    unsigned u = __float_as_uint(v); if (u == 0x80000000u) u = 0u;
    int k = (int)((u & 0x7fffffffu) >> 19) - (103 << 4);
    k = k < 0 ? 0 : (k > 511 ? 511 : k);
    return (u >> 31) ? (511 - k) : (512 + k);
}
__device__ __forceinline__ float relu_(float x) { const int i = __float_as_int(x); return __int_as_float(i > 0 ? i : 0); }
template <int PASS> __device__ __forceinline__ void idx_epilogue(const f32x16& accA, const f32x16& accB, int st, int lane, int l32, int hl, const float (&wq)[2][8], int b1l0, int b1l1,
                                                                 LAS unsigned* hist, int (&cc)[2], LAS unsigned long long* cand, LAS unsigned* mk) {
#pragma unroll
    for (int half = 0; half < 2; ++half) {
#pragma unroll
        for (int qq = 0; qq < 2; ++qq) { float I = 0.f;
#pragma unroll
            for (int h = 0; h < 8; ++h) I = __builtin_fmaf(wq[qq][h], relu_(half ? accB[8 * qq + h] : accA[8 * qq + h]), I);
            const int bin = score_bin(I); const int q = 2 * hl + qq;
            if (PASS == 1) { __hip_atomic_fetch_add(hist + q * 1024 + bin, 1u, __ATOMIC_RELAXED, __HIP_MEMORY_SCOPE_WORKGROUP); }
            else { const int bq = qq ? b1l1 : b1l0;
                const unsigned long long ms = __ballot(bin > bq);
                if (l32 == 0) mk[q * 256 + 2 * st + half] = hl ? (unsigned)(ms >> 32) : (unsigned)ms;
                const bool isCand = bin == bq; const unsigned long long mc = __ballot(isCand);
                if (mc) { const unsigned mine = hl ? (unsigned)(mc >> 32) : (unsigned)mc;
                    if (isCand) { const unsigned pos = (unsigned)cc[qq] + __builtin_popcount(mine & ((1u << l32) - 1u));
                        if (pos < 256u) { unsigned ub = __float_as_uint(I); if (ub == 0x80000000u) ub = 0u; ub = (ub >> 31) ? ~ub : (ub | 0x80000000u); cand[q * 256 + pos] = ((unsigned long long)ub << 32) | (unsigned long long)(0xffffu - (unsigned)(64 * st + 32 * half + l32)); } }
                    cc[qq] += __builtin_popcount(mine); } } }
    }
}
template <int PASS> __device__ __forceinline__ void idx_pass(const bf16* z, size_t rowb, int nst, LAS unsigned char* lds, const bf16x8 (&qa)[4], const float (&wq)[2][8], int b1l0, int b1l1,
                                                             LAS unsigned* hist, int (&cc)[2], LAS unsigned long long* cand, LAS unsigned* mk, const int TID) {
    const int lane = TID & 63, l32 = lane & 31, hl = lane >> 5;
    const int skey = 8 * (TID >> 6) + (TID & 7), sc = (TID >> 3) & 7;
    const bf16* gp = z + (rowb + skey) * ZS + C_IK + 8 * sc;
    LAS unsigned char* kst = lds + KST_OFF;
    const unsigned wofs = (unsigned)(((skey >> 5) * 4 + (sc >> 1)) * 1024 + ((sc & 1) * 32 + (skey & 31)) * 16);
    unsigned roA[4], roB[4];
#pragma unroll
    for (int ks = 0; ks < 4; ++ks) { roA[ks] = (unsigned)(ks * 1024 + lane * 16); roB[ks] = (unsigned)((4 + ks) * 1024 + lane * 16); }
    const int last = nst - 1;
#define IDX_LD(slot, stg) do { const int s_ = (stg) < last ? (stg) : last; GLD16(pre[slot], gp + (size_t)s_ * 64 * ZS); } while (0)
    v4u pre[4];
    asm volatile("s_waitcnt vmcnt(0)" ::: "memory");
#pragma unroll
    for (int i = 0; i < 4; ++i) IDX_LD(i, i);
    VM_WAIT(3, pre[0]);
    *(LAS v4u*)(kst + wofs) = pre[0];
    IDX_LD(0, 4);
    LDS_BAR();
    for (int st0 = 0; st0 < nst; st0 += 4) {
#pragma unroll
        for (int i = 0; i < 4; ++i) { const int st = st0 + i; if (st < nst) {
            LAS unsigned char* cur = kst + (i & 1) * 8192;
            f32x16 accA = {}, accB = {};
            { bf16x8 ka[4], kb[4];
#pragma unroll
              for (int ks = 0; ks < 4; ++ks) { ka[ks] = *(const LAS bf16x8*)(cur + roA[ks]); kb[ks] = *(const LAS bf16x8*)(cur + roB[ks]); }
              __builtin_amdgcn_sched_barrier(0);
#pragma unroll
              for (int ks = 0; ks < 4; ++ks) { accA = __builtin_amdgcn_mfma_f32_32x32x16_bf16(qa[ks], ka[ks], accA, 0, 0, 0); accB = __builtin_amdgcn_mfma_f32_32x32x16_bf16(qa[ks], kb[ks], accB, 0, 0, 0); } }
            VM_WAIT(3, pre[(i + 1) & 3]);
            *(LAS v4u*)(kst + ((i + 1) & 1) * 8192 + wofs) = pre[(i + 1) & 3]; IDX_LD((i + 1) & 3, st + 5);
            idx_epilogue<PASS>(accA, accB, st, lane, l32, hl, wq, b1l0, b1l1, hist, cc, cand, mk);
            LDS_BAR();
        } }
    }
#undef IDX_LD
    asm volatile("s_waitcnt vmcnt(0)" ::: "memory");
}
__device__ __forceinline__ void dsa_select_item(const bf16* z, unsigned* mask, int b, int qt, LAS unsigned char* lds, const int TID) {
    const int lane = TID & 63, wave = __builtin_amdgcn_readfirstlane(TID >> 6), l32 = lane & 31, hl = lane >> 5;
    LAS unsigned char* R = lds + wave * 16384;
    LAS unsigned* hist = (LAS unsigned*)R;
    const size_t rowb = (size_t)b * SEQ; const int t0 = 32 * qt + 4 * wave; const int nadm = 64 * ((qt >> 1) + 1);
    LAS unsigned long long* cand = (LAS unsigned long long*)(R + DS_CV); LAS unsigned* mk = (LAS unsigned*)(R + DS_LG);
    if (nadm > TOPK) {
        bf16x8 qa[4];
        { const int i = l32, ql = 2 * ((i >> 2) & 1) + (i >> 4), hd = 4 * ((i >> 3) & 1) + (i & 3);
          const bf16* qp = z + (rowb + t0 + ql) * ZS + C_IQ + hd * 64 + 8 * hl;
#pragma unroll
          for (int ks = 0; ks < 4; ++ks) qa[ks] = *(const bf16x8*)(qp + 16 * ks); }
        float wq[2][8];
#pragma unroll
        for (int qq = 0; qq < 2; ++qq) { const v4u ww = *(const v4u*)(z + (rowb + t0 + 2 * hl + qq) * ZS + C_IW); const float sc = 0.044194173824159216f;
            wq[qq][0] = bflo(ww.x) * sc; wq[qq][1] = bfhi(ww.x) * sc; wq[qq][2] = bflo(ww.y) * sc; wq[qq][3] = bfhi(ww.y) * sc; wq[qq][4] = bflo(ww.z) * sc; wq[qq][5] = bfhi(ww.z) * sc; wq[qq][6] = bflo(ww.w) * sc; wq[qq][7] = bfhi(ww.w) * sc; }
        for (int i = lane; i < 1024; i += 64) *(LAS v4u*)(R + i * 16) = (v4u){0u, 0u, 0u, 0u};
        LDS_FENCE();
        int cc[2] = {0, 0};
        idx_pass<1>(z, rowb, nadm >> 6, lds, qa, wq, 0, 0, hist, cc, cand, mk, TID);
        LDS_FENCE();
        int b1[4], cab[4];
        { int tot[4], incl[4];
#pragma unroll
          for (int q = 0; q < 4; ++q) { const LAS v4u* hp = (const LAS v4u*)(hist + q * 1024 + 1008 - 16 * lane); const v4u a = hp[0], bb = hp[1], c = hp[2], d = hp[3];
              tot[q] = (int)((a.x + a.y + a.z + a.w) + (bb.x + bb.y + bb.z + bb.w) + (c.x + c.y + c.z + c.w) + (d.x + d.y + d.z + d.w)); incl[q] = tot[q]; }
#pragma unroll
          for (int o = 1; o < 64; o <<= 1) {
#pragma unroll
              for (int q = 0; q < 4; ++q) { const int tv = __shfl_up(incl[q], o); if (lane >= o) incl[q] += tv; } }
#pragma unroll
          for (int q = 0; q < 4; ++q) { const unsigned long long mkb = __ballot(incl[q] >= TOPK); const int F = __builtin_ctzll(mkb);
              int cum = __builtin_amdgcn_readfirstlane(__shfl(incl[q] - tot[q], F));
              const int base = 1008 - 16 * F; const LAS v4u* hp = (const LAS v4u*)(hist + q * 1024 + base); const v4u a = hp[0], bb = hp[1], c = hp[2], d = hp[3];
              const unsigned v[16] = {a.x, a.y, a.z, a.w, bb.x, bb.y, bb.z, bb.w, c.x, c.y, c.z, c.w, d.x, d.y, d.z, d.w};
              int bq = base, cq = cum; bool found = false;
#pragma unroll
              for (int j = 15; j >= 0; --j) { const int nxt = cum + (int)v[j]; if (!found && nxt >= TOPK) { bq = base + j; cq = cum; found = true; } cum = nxt; }
              b1[q] = __builtin_amdgcn_readfirstlane(bq); cab[q] = __builtin_amdgcn_readfirstlane(cq); } }
        LDS_FENCE();
        idx_pass<2>(z, rowb, nadm >> 6, lds, qa, wq, hl ? b1[2] : b1[0], hl ? b1[3] : b1[1], hist, cc, cand, mk, TID);
        LDS_FENCE();
        const int nc0 = __builtin_amdgcn_readfirstlane(__shfl(cc[0], 0)), nc1 = __builtin_amdgcn_readfirstlane(__shfl(cc[1], 0)), nc2 = __builtin_amdgcn_readfirstlane(__shfl(cc[0], 32)), nc3 = __builtin_amdgcn_readfirstlane(__shfl(cc[1], 32));
#pragma unroll
        for (int q = 0; q < 4; ++q) { const int ncr = q == 0 ? nc0 : (q == 1 ? nc1 : (q == 2 ? nc2 : nc3)); const int nc = min(ncr, 256); const int need = TOPK - cab[q];
            const LAS unsigned long long* ck = cand + q * 256;
            unsigned long long mine[4]; int rank[4];
#pragma unroll
            for (int c = 0; c < 4; ++c) { mine[c] = (lane + 64 * c < nc) ? ck[lane + 64 * c] : ~0ull; rank[c] = 0; }
#pragma unroll 8
            for (int j = 0; j < nc; ++j) { const unsigned long long kj = ck[j];
#pragma unroll
                for (int c = 0; c < 4; ++c) rank[c] += (kj > mine[c]) ? 1 : 0; }
#pragma unroll
            for (int c = 0; c < 4; ++c) if (lane + 64 * c < nc && rank[c] < need) { const unsigned key = 0xffffu - (unsigned)(mine[c] & 0xffffull); __hip_atomic_fetch_or(mk + q * 256 + (key >> 5), 1u << (key & 31), __ATOMIC_RELAXED, __HIP_MEMORY_SCOPE_WORKGROUP); }
        }
        LDS_FENCE();
    } else {
        for (int i = lane; i < 256; i += 64) *(LAS v4u*)(R + DS_LG + i * 16) = (v4u){0u, 0u, 0u, 0u};
        LDS_FENCE();
#pragma unroll
        for (int q = 0; q < 4; ++q) for (int w = lane; w < (nadm >> 5); w += 64) mk[q * 256 + w] = 0xffffffffu;
        LDS_FENCE();
    }
#pragma unroll
    for (int q = 0; q < 4; ++q) ((v4u*)(mask + (rowb + t0 + q) * 256))[lane] = *(const LAS v4u*)(mk + q * 256 + 4 * lane);
    LDS_FENCE();
}
constexpr int AT_K = 0, AT_V = 16384;
__device__ __forceinline__ unsigned pk2t(float lo, float hi) { unsigned r; asm volatile("v_cvt_pk_bf16_f32 %0, %1, %2" : "=v"(r) : "v"(lo), "v"(hi)); return r; }
__device__ __forceinline__ void attn_unit(const bf16* z, bf16* O, int opitch, const unsigned* mask, int b, int h, int qb, LAS unsigned char* lds, const int TID) {
    const int lane = TID & 63, wave = __builtin_amdgcn_readfirstlane(TID >> 6), l32 = lane & 31, hl = lane >> 5;
    const size_t rowb = (size_t)b * SEQ; const int myq = 256 * qb + 32 * wave + l32; const int cw = 4 * qb + (wave >> 1), nt = 4 * qb + 4;
    bf16x8 qf[4];
    { const bf16* qp = z + (rowb + myq) * ZS + C_AQ + h * 64 + 8 * hl;
#pragma unroll
      for (int ks = 0; ks < 4; ++ks) qf[ks] = *(const bf16x8*)(qp + 16 * ks); }
    const unsigned long long* mrow = (const unsigned long long*)(mask + (rowb + myq) * 256);
    const int skey = TID >> 3, sc = TID & 7;
    const bf16* kg = z + (rowb + skey) * ZS + C_AK + h * 64 + 8 * sc; const bf16* vg = z + (rowb + skey) * ZS + C_AV + h * 64 + 8 * sc;
    const unsigned kofs = kswz(skey, sc);
    const unsigned vwofs = vrow(skey, sc);
    const int tq = (lane >> 2) & 3, tp = lane & 3, tg = (lane >> 4) & 1;
    v4u kpre[2], vpre[2]; unsigned long long mwv[2];
#pragma unroll
    for (int i = 0; i < 2; ++i) { kpre[i] = *(const v4u*)(kg + (size_t)i * 64 * ZS); vpre[i] = *(const v4u*)(vg + (size_t)i * 64 * ZS); mwv[i] = mrow[i]; }
#define AT_WRITE(bufsel, sl) do { *(LAS v4u*)(lds + AT_K + (bufsel) * 8192 + kofs) = kpre[sl]; *(LAS v4u*)(lds + AT_V + (bufsel) * 8192 + vwofs) = vpre[sl]; } while (0)
    AT_WRITE(0, 0);
    LDS_BAR();
    f32x16 o0 = {}, o1 = {}; float m = -INFINITY, l = 0.f;
    const float SC = 0.18033688011112042f;
    for (int t0 = 0; t0 < nt; t0 += 2) {
#pragma unroll
        for (int i = 0; i < 2; ++i) { const int t = t0 + i;
            const unsigned long long mw = mwv[i];
            if (t + 2 < nt) { kpre[i] = *(const v4u*)(kg + (size_t)(t + 2) * 64 * ZS); vpre[i] = *(const v4u*)(vg + (size_t)(t + 2) * 64 * ZS); mwv[i] = mrow[t + 2]; }
            if (t <= cw) {
                LAS unsigned char* curK = lds + AT_K + i * 8192; LAS unsigned char* curV = lds + AT_V + i * 8192;
                f32x16 s0 = {}, s1 = {};
                { bf16x8 a0[4], a1[4];
#pragma unroll
                  for (int ks = 0; ks < 4; ++ks) { a0[ks] = *(const LAS bf16x8*)(curK + kswz(l32, 2 * ks + hl)); a1[ks] = *(const LAS bf16x8*)(curK + kswz(32 + l32, 2 * ks + hl)); }
                  __builtin_amdgcn_sched_barrier(0);
#pragma unroll
                  for (int ks = 0; ks < 4; ++ks) { s0 = __builtin_amdgcn_mfma_f32_32x32x16_bf16(a0[ks], qf[ks], s0, 0, 0, 0); s1 = __builtin_amdgcn_mfma_f32_32x32x16_bf16(a1[ks], qf[ks], s1, 0, 0, 0); } }
                __builtin_amdgcn_sched_barrier(0);
                const int mlo = (int)((unsigned)mw >> (4 * hl)), mhi = (int)((unsigned)(mw >> 32) >> (4 * hl));
                float ta = -INFINITY, tb = -INFINITY;
#pragma unroll
                for (int r = 0; r < 16; ++r) { const int bit = (r & 3) + 8 * (r >> 2);
                    const unsigned x0 = (unsigned)__builtin_amdgcn_sbfe(mlo, bit, 1), x1 = (unsigned)__builtin_amdgcn_sbfe(mhi, bit, 1);
                    s0[r] = __uint_as_float((x0 & __float_as_uint(s0[r])) | (~x0 & 0xff800000u)); s1[r] = __uint_as_float((x1 & __float_as_uint(s1[r])) | (~x1 & 0xff800000u));
                    if (r & 1) tb = __builtin_fmaxf(__builtin_fmaxf(tb, s0[r]), s1[r]); else ta = __builtin_fmaxf(__builtin_fmaxf(ta, s0[r]), s1[r]); }
                float tmax = __builtin_fmaxf(ta, tb);
                tmax = __builtin_fmaxf(tmax, __shfl_xor(tmax, 32));
                const float mnew = __builtin_fmaxf(m, tmax); const float mref = (mnew == -INFINITY) ? 0.f : mnew;
                const float alpha = __builtin_amdgcn_exp2f((m - mref) * SC); const float nb = -mref * SC;
                float ps = 0.f;
#pragma unroll
                for (int r = 0; r < 16; ++r) { s0[r] = __builtin_amdgcn_exp2f(__builtin_fmaf(s0[r], SC, nb)); s1[r] = __builtin_amdgcn_exp2f(__builtin_fmaf(s1[r], SC, nb)); ps += s0[r] + s1[r]; }
                l = l * alpha + ps; m = mnew;
                if (__any(alpha != 1.0f)) {
#pragma unroll
                    for (int r = 0; r < 16; ++r) { o0[r] *= alpha; o1[r] *= alpha; } }
                v4u pw[4];
                pw[0] = (v4u){pk2t(s0[0], s0[1]), pk2t(s0[2], s0[3]), pk2t(s0[4], s0[5]), pk2t(s0[6], s0[7])}; pw[1] = (v4u){pk2t(s0[8], s0[9]), pk2t(s0[10], s0[11]), pk2t(s0[12], s0[13]), pk2t(s0[14], s0[15])};
                pw[2] = (v4u){pk2t(s1[0], s1[1]), pk2t(s1[2], s1[3]), pk2t(s1[4], s1[5]), pk2t(s1[6], s1[7])}; pw[3] = (v4u){pk2t(s1[8], s1[9]), pk2t(s1[10], s1[11]), pk2t(s1[12], s1[13]), pk2t(s1[14], s1[15])};
                { v4i16_t va[4][2], vb[4][2];
#pragma unroll
                  for (int s = 0; s < 4; ++s) {
#pragma unroll
                      for (int pc = 0; pc < 2; ++pc) { const int row = 16 * s + 8 * pc + 4 * hl + tq;
                          const int c0 = 2 * tg + (tp >> 1);
                          va[s][pc] = __builtin_amdgcn_ds_read_tr16_b64_v4i16((LAS v4i16_t*)(curV + vrow(row, c0) + 8 * (tp & 1)));
                          vb[s][pc] = __builtin_amdgcn_ds_read_tr16_b64_v4i16((LAS v4i16_t*)(curV + vrow(row, 4 + c0) + 8 * (tp & 1))); } }
                  __builtin_amdgcn_sched_barrier(0);
#pragma unroll
                  for (int s = 0; s < 4; ++s) { const bf16x8 pf = __builtin_bit_cast(bf16x8, pw[s]);
                      const bf16x8 fa = (bf16x8){va[s][0][0], va[s][0][1], va[s][0][2], va[s][0][3], va[s][1][0], va[s][1][1], va[s][1][2], va[s][1][3]};
                      const bf16x8 fb = (bf16x8){vb[s][0][0], vb[s][0][1], vb[s][0][2], vb[s][0][3], vb[s][1][0], vb[s][1][1], vb[s][1][2], vb[s][1][3]};
                      o0 = __builtin_amdgcn_mfma_f32_32x32x16_bf16(fa, pf, o0, 0, 0, 0); o1 = __builtin_amdgcn_mfma_f32_32x32x16_bf16(fb, pf, o1, 0, 0, 0); } }
            }
        if (t + 1 < nt) AT_WRITE((i + 1) & 1, (i + 1) & 1);
            LDS_BAR();
        }
    }
#undef AT_WRITE
    l += __shfl_xor(l, 32);
    const float inv = 1.0f / l;
    bf16* orow = O + (rowb + myq) * opitch + h * 64 + 4 * hl;
#pragma unroll
    for (int g = 0; g < 4; ++g) {
        *(v2u*)(orow + 8 * g) = (v2u){pk2t(o0[4 * g] * inv, o0[4 * g + 1] * inv), pk2t(o0[4 * g + 2] * inv, o0[4 * g + 3] * inv)};
        *(v2u*)(orow + 32 + 8 * g) = (v2u){pk2t(o1[4 * g] * inv, o1[4 * g + 1] * inv), pk2t(o1[4 * g + 2] * inv, o1[4 * g + 3] * inv)}; }
}
#ifndef PHSEQ
#define PHSEQ 0,1,2,3,4,5,6,7,9,10,11,12,13,14,15
#endif
__device__ const unsigned char kPhSeq[] = {PHSEQ};
constexpr int PH_PER_LAYER = (int)sizeof(kPhSeq), PH_FINAL = DEPTH * PH_PER_LAYER, PH_TOTAL = PH_FINAL + 1;
#ifndef PHMASK
#define PHMASK 0x1FFFF
#endif
#ifndef MK_ONE_LAUNCH
#define MK_ONE_LAUNCH 1
#endif
__global__ void __launch_bounds__(NTHREADS, 2) mega_fwd(Args a_) {
    extern __shared__ __attribute__((aligned(16))) unsigned char lds_raw[];
    LAS unsigned char* lds = (LAS unsigned char*)lds_raw;
    const int ph_lo = a_.ph_lo, ph_hi = a_.ph_hi; unsigned char* const ws0 = a_.ws;
    for (int u = threadIdx.x; u < (LDS_BYTES - LDSCTL_OFF) / 4; u += NTHREADS) ((LAS unsigned*)(lds + LDSCTL_OFF))[u] = 0u;
    __syncthreads();
    XcdBarrier bar; bar.bar = (unsigned*)(a_.ws + WS_CTL); bar.x = 0; bar.st = (volatile LAS unsigned*)(lds + LDSCTL_OFF + 1024);
    if (ph_lo > ph_hi) cg::this_grid().sync();
    if (ph_hi - ph_lo > 1) bar = xcd_barrier_post((unsigned*)(a_.ws + WS_CTL), (volatile LAS unsigned*)(lds + LDSCTL_OFF + 1024));
    for (int ph = ph_lo; ph < ph_hi; ++ph) {
        ArgsP ap = (ArgsP)__builtin_amdgcn_kernarg_segment_ptr(); asm volatile("" : "+s"(ap));
        const int G = gridDim.x; unsigned char* ws = ap->ws;
        bf16* Hb = (bf16*)(ws + WS_H); bf16* Z = (bf16*)(ws + WS_Z); float* dS = (float*)(ws + WS_H); float* Adec = (float*)(ws + WS_SMALL);
        float* PPf = (float*)(ws + WS_Z); bf16* PB = (bf16*)(ws + WS_PB); unsigned* MASK = (unsigned*)(ws + WS_MASK); float* PART = (float*)(ws + WS_PART); bf16* XB2 = (bf16*)(ws + WS_XB2);
        float* X = ap->out;
        int TID = threadIdx.x, BID = blockIdx.x; asm volatile("" : "+v"(TID)); asm volatile("" : "+s"(BID));
        const int lane = TID & 63, wave = __builtin_amdgcn_readfirstlane(TID >> 6);
        if (ph == PH_FINAL) { norm_rows_f32(X, ap->in[21], wave, lane, TID, BID); }
        else {
            const int L = ph / PH_PER_LAYER, k = kPhSeq[ph % PH_PER_LAYER];
            const float* xin = (L == 0) ? ap->in[0] : (const float*)X;
            switch (k) {
            case 0: if (PHMASK & (1 << 0)) {
                convert_weights(ap, L, lds, wave, lane, TID, BID);
                norm_rows(xin, ap->in[9] + L * D, Hb, wave, lane, TID, BID);
            } break;
            case 1: if (PHMASK & (1 << 1)) {
                pg8::Gemm g{Hb, (const bf16*)(ws + WB_GU1), T, 2 * FF, D, D, D}; pg8::StaticOrder S; S.init(T, 2 * FF, G, (int)BID);
                pg8::EpiSwiGLU E{Z, FF, nullptr};
                pg8::gemm_phase<pg8::EpiSwiGLU, pg8::StaticOrder, true, true>(lds, g, S, E, TID);
            } break;
            case 2: if (PHMASK & (1 << 2)) {
                pg8::Gemm g{Z, (const bf16*)(ws + WB_D1), T, D, FF, FF, FF}; pg8::StaticOrder S; S.init(T, D, G, (int)BID);
                pg8::EpiResid E{xin, X, D, 0.5f};
                pg8::gemm_phase<pg8::EpiResid, pg8::StaticOrder, true, true>(lds, g, S, E, TID);
            } break;
            case 3: if (PHMASK & (1 << 3)) { norm_rows(X, ap->in[10] + L * D, Hb, wave, lane, TID, BID); } break;
            case 4: if (PHMASK & (1 << 4)) {
                pg8::Gemm g{Hb, (const bf16*)(ws + WB_IN), T, WINP, D, D, D}; pg8::StaticOrder S; S.init(T, WINP, G, (int)BID);
                pg8::EpiBf16Mask E{Z, ZS, WIN, nullptr};
                pg8::gemm_phase<pg8::EpiBf16Mask, pg8::StaticOrder, true, true>(lds, g, S, E, TID);
            } break;
            case 5: if (PHMASK & (1 << 5)) {
                for (int it = BID; it < 1024; it += G) gla_local_item(Z, it, ap->in[3] + L * 16 * 256, ap->in[4] + L * 256, dS, Adec, lds, TID);
                for (int it = BID; it < 512; it += G) { const int b = it >> 8, j = it & 255; const int qt = b ? (255 - j) : j; dsa_select_item(Z, MASK, b, qt, lds, TID); }
            } break;
            case 6: if (PHMASK & (1 << 6)) { gla_scan(dS, Adec, TID, BID); } break;
            case 7: if (PHMASK & (1 << 7)) {
                for (int it = BID; it < 1024; it += G) gla_out_item(Z, it, ap->in[3] + L * 16 * 256, ap->in[4] + L * 256, ap->in[5] + L * 128, dS, lds, TID);
                const int vcu = (G % 8 == 0) ? ((int)BID % 8) * (G / 8) + (int)BID / 8 : (int)BID;
                for (int it = vcu; it < 256; it += G) { const int bh = it >> 4, s = it & 15; attn_unit(Z, Z + C_AQ, ZS, MASK, bh >> 3, bh & 7, s, lds, TID); attn_unit(Z, Z + C_AQ, ZS, MASK, bh >> 3, bh & 7, 31 - s, lds, TID); }
            } break;
            case 8: if (PHMASK & (1 << 8)) {
                const int vcu = (G % 8 == 0) ? ((int)BID % 8) * (G / 8) + (int)BID / 8 : (int)BID;
                for (int it = vcu; it < 256; it += G) { const int bh = it >> 4, s = it & 15; attn_unit(Z, Z + C_AQ, ZS, MASK, bh >> 3, bh & 7, s, lds, TID); attn_unit(Z, Z + C_AQ, ZS, MASK, bh >> 3, bh & 7, 31 - s, lds, TID); }
            } break;
            case 17: {
                for (int it = BID; it < 512; it += G) { const int b = it >> 8, j = it & 255; const int qt = b ? (255 - j) : j; dsa_select_item(Z, MASK, b, qt, lds, TID); }
            } break;
            case 19: {
                bf16* DUM = (bf16*)(ws + WS_ALL);
                for (int it = BID; it < 256; it += G) { const int bh = it >> 4, s = it & 15; attn_unit(Z, DUM, 512, MASK, bh >> 3, bh & 7, s, lds, TID); attn_unit(Z, DUM, 512, MASK, bh >> 3, bh & 7, 31 - s, lds, TID); }
            } break;
            case 9: if (PHMASK & (1 << 9)) {
                { pg8::Gemm g{Z + C_AQ, (const bf16*)(ws + WB_A), T, D, 512, ZS, 512}; pg8::StaticOrder S; S.init(T, D, G, (int)BID);
                  pg8::EpiMerge<0> E{Z + C_MGA, ZS, Hb, D};
                  pg8::gemm_phase<pg8::EpiMerge<0>, pg8::StaticOrder, true, true>(lds, g, S, E, TID); }
                { pg8::Gemm g{Z + C_GV, (const bf16*)(ws + WB_B), T, D, 512, ZS, 512}; pg8::StaticOrder S; S.init(T, D, G, (int)BID);
                  pg8::EpiMerge<1> E{Z + C_MGB, ZS, Hb, D};
                  pg8::gemm_phase<pg8::EpiMerge<1>, pg8::StaticOrder, true, true>(lds, g, S, E, TID); }
            } break;
            case 10: if (PHMASK & (1 << 10)) {
                pg8::Gemm g{Hb, (const bf16*)(ws + WB_O), T, D, D, D, D}; pg8::StaticOrder S; S.init(T, D, G, (int)BID);
                pg8::EpiResid E{X, X, D, 1.0f};
                pg8::gemm_phase<pg8::EpiResid, pg8::StaticOrder, true, true>(lds, g, S, E, TID);
            } break;
            case 11: if (PHMASK & (1 << 11)) { norm_rows(X, ap->in[11] + L * D, Hb, wave, lane, TID, BID); } break;
            case 12: if (PHMASK & (1 << 12)) {
                pg8::Gemm g{Hb, (const bf16*)(ws + WB_GU2), T, 2 * FF, D, D, D}; pg8::StaticOrder S; S.init(T, 2 * FF, G, (int)BID);
                pg8::EpiSwiGLU E{Z, FF, nullptr};
                pg8::gemm_phase<pg8::EpiSwiGLU, pg8::StaticOrder, true, true>(lds, g, S, E, TID);
            } break;
            case 13: if (PHMASK & (1 << 13)) {
                pg8::Gemm g{Z, (const bf16*)(ws + WB_D2), T, D, FF, FF, FF}; pg8::StaticOrder S; S.init(T, D, G, (int)BID);
                pg8::EpiResid E{X, X, D, 0.5f};
                pg8::gemm_phase<pg8::EpiResid, pg8::StaticOrder, true, true>(lds, g, S, E, TID);
                convert_p(ap->in[1] + (size_t)L * T * PLE, PB, TID, BID);
            } break;
            case 14: if (PHMASK & (1 << 14)) { norm_rows(X, ap->in[12] + L * D, Hb, wave, lane, TID, BID); } break;
            case 15: if (PHMASK & (1 << 15)) {
                pg8::Gemm g{PB, (const bf16*)(ws + WB_PP), T, D, PLE, PLE, PLE}; pg8::StaticOrder S; S.init(T, D, G, (int)BID);
                pg8::EpiF32 E{PPf, D};
                pg8::gemm_phase<pg8::EpiF32, pg8::StaticOrder, true, true>(lds, g, S, E, TID);
                asm volatile("s_waitcnt vmcnt(0)" ::: "memory");
              {
                pg8::Gemm g{Hb, (const bf16*)(ws + WB_PG), T, D, D, D, D}; pg8::StaticOrder S; S.init(T, D, G, (int)BID);
                pg8::EpiPle E{PPf, X, D, nullptr};
                pg8::gemm_phase<pg8::EpiPle, pg8::StaticOrder, true, true>(lds, g, S, E, TID);
              } } break;

            }
        }
        if (ph + 1 < ph_hi) xcd_barrier(bar);
    }
}

extern "C" void kernel_launch(void* const* d_in, const int* in_sizes, int n_in, void* d_out, int out_size, void* d_ws, size_t ws_size, hipStream_t stream) {
    static int grid = 0;
    if (grid == 0) {
        if (n_in != 22 || out_size != T * D || ws_size < WS_ALL) { fprintf(stderr, "kernel_launch: unexpected shapes (n_in %d out %d ws %zu need %zu)\n", n_in, out_size, ws_size, (size_t)WS_END); grid = -1; return; }
        int dev = 0, cus = 0, per_cu = 0;
        hipGetDevice(&dev); hipDeviceGetAttribute(&cus, hipDeviceAttributeMultiprocessorCount, dev);
        if (hipFuncSetAttribute((const void*)mega_fwd, hipFuncAttributeMaxDynamicSharedMemorySize, LDS_BYTES) != hipSuccess) { fprintf(stderr, "kernel_launch: hipFuncSetAttribute failed\n"); grid = -1; return; }
        if (hipOccupancyMaxActiveBlocksPerMultiprocessor(&per_cu, (const void*)mega_fwd, NTHREADS, LDS_BYTES) != hipSuccess || per_cu < 1) { fprintf(stderr, "kernel_launch: occupancy query says %d\n", per_cu); (void)hipGetLastError(); grid = -1; return; }
        grid = cus;
    }
    if (grid < 0) return;
    if (hipMemsetAsync((char*)d_ws + WS_CTL, 0, 16384, stream) != hipSuccess) { fprintf(stderr, "kernel_launch: memset failed\n"); return; }
    Args a{};
    for (int i = 0; i < 22; ++i) a.in[i] = (const float*)d_in[i];
    a.out = (float*)d_out; a.ws = (unsigned char*)d_ws;
#if MK_ONE_LAUNCH
    a.ph_lo = 0; a.ph_hi = PH_TOTAL;
    void* args[] = {&a};
    hipError_t e = hipLaunchCooperativeKernel((const void*)mega_fwd, dim3(grid), dim3(NTHREADS), args, LDS_BYTES, stream);
    if (e != hipSuccess) fprintf(stderr, "cooperative launch failed: %s (grid %d)\n", hipGetErrorString(e), grid);
#else
    for (int ph = 0; ph < PH_TOTAL; ++ph) { a.ph_lo = ph; a.ph_hi = ph + 1; hipLaunchKernelGGL(mega_fwd, dim3(grid), dim3(NTHREADS), LDS_BYTES, stream, a); }
#endif
}
```
